# Optimizing an MI355X kernel written in HIP

```python
import jax, jax.numpy as jnp
from jax import lax
import numpy as np

D_MODEL = 1024
BATCH = 8
SEQ = 2048
DEPTH = 1
DEC_BATCH = 16
DEC_SEQ = 64
PAST_LEN = 2048

CHUNK = 64
HEAD_DIM = 64
N_HEADS = 8
N_KV_HEADS = 2
GROUP = N_HEADS // N_KV_HEADS
ATTN_WIDTH = N_HEADS * HEAD_DIM
KV_WIDTH = N_KV_HEADS * HEAD_DIM
WINDOW = 128
WIN_CACHE = min(WINDOW, PAST_LEN)
ROPE_THETA = 10000.0
RET_HEADS = 4
RET_HEAD_DIM = 128
RET_WIDTH = RET_HEADS * RET_HEAD_DIM
RET_THETA = 10000.0
MIX_WIDTH = ATTN_WIDTH + RET_WIDTH
D_FF = 4 * D_MODEL
EPS = 1e-6
SPLITS = [ATTN_WIDTH,
          ATTN_WIDTH + KV_WIDTH,
          ATTN_WIDTH + 2 * KV_WIDTH,
          ATTN_WIDTH + 2 * KV_WIDTH + RET_WIDTH,
          ATTN_WIDTH + 2 * KV_WIDTH + 2 * RET_WIDTH,
          ATTN_WIDTH + 2 * KV_WIDTH + 3 * RET_WIDTH]
IN_WIDTH = ATTN_WIDTH + 2 * KV_WIDTH + 4 * RET_WIDTH

kernel_name = 'hymba_swa_sink_retention_stream_step'


def _rmsnorm(x, gain):
    xf = x.astype(jnp.float32)
    y = xf * lax.rsqrt(jnp.mean(xf * xf, axis=-1, keepdims=True) + EPS)
    return (y * gain.astype(jnp.float32)).astype(x.dtype)


def _attn_inv_freq():
    return 1.0 / (ROPE_THETA ** (jnp.arange(0, HEAD_DIM, 2, dtype=jnp.float32) / HEAD_DIM))


def _ret_inv_freq():
    return 1.0 / (RET_THETA ** jnp.linspace(0.0, 1.0, RET_HEAD_DIM // 2, dtype=jnp.float32))


def _ret_log_decay():
    return jnp.log1p(-jnp.exp2(-5.0 - jnp.arange(RET_HEADS, dtype=jnp.float32)))


def _rotate(x, pos, inv_freq):
    ang = pos.astype(jnp.float32)[:, None] * inv_freq[None, :]
    cos = jnp.cos(ang)[None, :, None, :]
    sin = jnp.sin(ang)[None, :, None, :]
    xf = x.astype(jnp.float32)
    x1, x2 = jnp.split(xf, 2, axis=-1)
    return jnp.concatenate([x1 * cos - x2 * sin, x2 * cos + x1 * sin], axis=-1).astype(x.dtype)


def _project(a, w_in, pos):
    B, L, _ = a.shape
    z = a @ w_in
    qa, ka, va, qr, kr, vr, gr = jnp.split(z, SPLITS, axis=-1)
    qa = _rotate(qa.reshape(B, L, N_HEADS, HEAD_DIM), pos, _attn_inv_freq())
    ka = _rotate(ka.reshape(B, L, N_KV_HEADS, HEAD_DIM), pos, _attn_inv_freq())
    va = va.reshape(B, L, N_KV_HEADS, HEAD_DIM)
    qr = _rotate(qr.reshape(B, L, RET_HEADS, RET_HEAD_DIM), pos, _ret_inv_freq())
    kr = _rotate(kr.reshape(B, L, RET_HEADS, RET_HEAD_DIM), pos, _ret_inv_freq()) * (RET_HEAD_DIM ** -0.5)
    vr = vr.reshape(B, L, RET_HEADS, RET_HEAD_DIM)
    return qa, ka, va, qr, kr, vr, gr


def _attend(q, k, v, sinks, mask):
    s = jnp.einsum('...qkgd,...skd->...kgqs', q, k).astype(jnp.float32) * (HEAD_DIM ** -0.5)
    if mask is not None:
        s = jnp.where(mask, s, -jnp.inf)
    sink = sinks.astype(jnp.float32).reshape(N_KV_HEADS, GROUP, 1)
    m = jnp.maximum(jnp.max(s, axis=-1), sink)
    p = jnp.exp(s - m[..., None])
    denom = jnp.sum(p, axis=-1) + jnp.exp(sink - m)
    p = (p / denom[..., None]).astype(v.dtype)
    o = jnp.einsum('...kgqs,...skd->...qkgd', p, v)
    return o.reshape(o.shape[:-3] + (ATTN_WIDTH,))


def _swa_prompt(q, k, v, sinks):
    B, S = q.shape[:2]
    n_c = S // CHUNK
    P = WINDOW // CHUNK
    qb = q.reshape(B, n_c, CHUNK, N_KV_HEADS, GROUP, HEAD_DIM)

    def band(t):
        tp = jnp.pad(t, ((0, 0), (WINDOW, 0), (0, 0), (0, 0)))
        tp = tp.reshape(B, n_c + P, CHUNK, N_KV_HEADS, HEAD_DIM)
        return jnp.concatenate([tp[:, j:j + n_c] for j in range(P + 1)], axis=2)

    kb, vb = band(k), band(v)
    key_pos = (jnp.arange(n_c)[:, None] - P) * CHUNK + jnp.arange((P + 1) * CHUNK)[None, :]
    mask = (key_pos >= 0)[:, None, None, None, :]
    o = _attend(qb, kb, vb, sinks, mask)
    return o.reshape(B, S, ATTN_WIDTH)


def _retention_chunk(state, q, k, v, log_g):
    L = q.shape[1]
    idx = jnp.arange(L, dtype=jnp.float32)
    diff = idx[:, None] - idx[None, :]
    decay = jnp.where(diff >= 0, jnp.exp(log_g[:, None, None] * jnp.maximum(diff, 0.0)), 0.0)
    sc = jnp.einsum('bihd,bjhd->bhij', q, k) * decay[None]
    intra = jnp.einsum('bhij,bjhe->bihe', sc, v)
    q_dec = jnp.exp(log_g[None, :] * (idx[:, None] + 1.0))
    cross = jnp.einsum('bihd,bhde->bihe', q, state) * q_dec[None, :, :, None]
    k_dec = jnp.exp(log_g[None, :] * (L - 1.0 - idx[:, None]))
    new_state = (jnp.exp(log_g * L)[None, :, None, None] * state
                 + jnp.einsum('bjhd,bjhe->bhde', k * k_dec[None, :, :, None], v))
    return intra + cross, new_state


def _retention_prompt(q, k, v):
    B, S, H, D = q.shape
    n_c = S // CHUNK
    log_g = _ret_log_decay()

    def to_chunks(t):
        return jnp.moveaxis(t.astype(jnp.float32).reshape(B, n_c, CHUNK, H, t.shape[-1]), 1, 0)

    def step(state, qkv):
        qc, kc, vc = qkv
        o, state = _retention_chunk(state, qc, kc, vc, log_g)
        return state, o

    s0 = jnp.zeros((B, H, D, RET_HEAD_DIM), jnp.float32)
    s_fin, o = lax.scan(step, s0, (to_chunks(q), to_chunks(k), to_chunks(v)))
    return jnp.moveaxis(o, 0, 1).reshape(B, S, H, RET_HEAD_DIM), s_fin


def _mix_out(attn_o, ret_o, gr, w_out):
    B, L = attn_o.shape[:2]
    r = ret_o * lax.rsqrt(jnp.mean(ret_o * ret_o, axis=-1, keepdims=True) + EPS)
    r = r.reshape(B, L, RET_WIDTH) * jax.nn.silu(gr.astype(jnp.float32))
    mixed = jnp.concatenate([attn_o, r.astype(attn_o.dtype)], axis=-1)
    return mixed @ w_out


def _sqrelu_mlp(a, w_up, w_down):
    u = jax.nn.relu(a @ w_up)
    return (u * u) @ w_down


def setup_inputs(seed: int = 0) -> dict:
    key = jax.random.key(seed)
    ks = jax.random.split(key, 16)
    f32 = jnp.float32
    x_prompt = jax.random.normal(ks[0], (BATCH, SEQ, D_MODEL), f32)
    x_sample = jax.random.normal(ks[1], (DEC_BATCH, DEC_SEQ, D_MODEL), f32)
    cache_k = jax.random.normal(ks[2], (DEPTH, DEC_BATCH, WIN_CACHE, N_KV_HEADS, HEAD_DIM), f32)
    cache_v = jax.random.normal(ks[3], (DEPTH, DEC_BATCH, WIN_CACHE, N_KV_HEADS, HEAD_DIM), f32)
    state_ret = jax.random.normal(ks[4], (DEPTH, DEC_BATCH, RET_HEADS, RET_HEAD_DIM, RET_HEAD_DIM), f32)
    norm1 = 1.0 + 0.05 * jax.random.normal(ks[5], (DEPTH, D_MODEL), f32)
    w_in = jax.random.normal(ks[6], (DEPTH, D_MODEL, IN_WIDTH), f32) * D_MODEL ** -0.5
    sinks = 0.5 * jax.random.normal(ks[7], (DEPTH, N_HEADS), f32)
    w_out = jax.random.normal(ks[8], (DEPTH, MIX_WIDTH, D_MODEL), f32) * MIX_WIDTH ** -0.5
    norm2 = 1.0 + 0.05 * jax.random.normal(ks[9], (DEPTH, D_MODEL), f32)
    w_up = jax.random.normal(ks[10], (DEPTH, D_MODEL, D_FF), f32) * D_MODEL ** -0.5
    w_down = jax.random.normal(ks[11], (DEPTH, D_FF, D_MODEL), f32) * D_FF ** -0.5
    norm_f = 1.0 + 0.05 * jax.random.normal(ks[12], (D_MODEL,), f32)
    return {'x_prompt': x_prompt, 'x_sample': x_sample, 'cache_k': cache_k, 'cache_v': cache_v,
            'state_ret': state_ret, 'norm1': norm1, 'w_in': w_in, 'sinks': sinks, 'w_out': w_out,
            'norm2': norm2, 'w_up': w_up, 'w_down': w_down, 'norm_f': norm_f}


def reference(x_prompt, x_sample, cache_k, cache_v, state_ret, norm1, w_in, sinks, w_out,
              norm2, w_up, w_down, norm_f):
    hp, hs = x_prompt, x_sample
    pos_p = jnp.arange(x_prompt.shape[1])
    pos_s = PAST_LEN + jnp.arange(x_sample.shape[1])
    nk_p, nv_p, ns_p, nk_s, nv_s, ns_s = [], [], [], [], [], []
    for l in range(DEPTH):
        a = _rmsnorm(hp, norm1[l])
        qa, ka, va, qr, kr, vr, gr = _project(a, w_in[l], pos_p)
        attn_o = _swa_prompt(qa, ka, va, sinks[l])
        ret_o, s_p = _retention_prompt(qr, kr, vr)
        hp = hp + _mix_out(attn_o, ret_o, gr, w_out[l])
        hp = hp + _sqrelu_mlp(_rmsnorm(hp, norm2[l]), w_up[l], w_down[l])
        nk_p.append(ka[:, -WIN_CACHE:])
        nv_p.append(va[:, -WIN_CACHE:])
        ns_p.append(s_p)
        a = _rmsnorm(hs, norm1[l])
        qa, ka, va, qr, kr, vr, gr = _project(a, w_in[l], pos_s)
        B, L = hs.shape[:2]
        k_all = jnp.concatenate([cache_k[l].astype(ka.dtype), ka], axis=1)
        v_all = jnp.concatenate([cache_v[l].astype(va.dtype), va], axis=1)
        attn_o = _attend(qa.reshape(B, L, N_KV_HEADS, GROUP, HEAD_DIM), k_all, v_all, sinks[l], None)
        ret_o, s_s = _retention_chunk(state_ret[l].astype(jnp.float32), qr.astype(jnp.float32),
                                      kr.astype(jnp.float32), vr.astype(jnp.float32), _ret_log_decay())
        hs = hs + _mix_out(attn_o, ret_o, gr, w_out[l])
        hs = hs + _sqrelu_mlp(_rmsnorm(hs, norm2[l]), w_up[l], w_down[l])
        nk_s.append(k_all[:, -WIN_CACHE:])
        nv_s.append(v_all[:, -WIN_CACHE:])
        ns_s.append(s_s)
    y_prompt = _rmsnorm(hp, norm_f)
    y_sample = _rmsnorm(hs, norm_f)
    return (y_prompt, y_sample,
            jnp.stack(nk_p, 0), jnp.stack(nv_p, 0), jnp.stack(ns_p, 0),
            jnp.stack(nk_s, 0), jnp.stack(nv_s, 0), jnp.stack(ns_s, 0))
```

```cpp
#include <hip/hip_runtime.h>
#include <cstdio>
#include <cstdint>

#define DI __device__ __forceinline__
#define LAS __attribute__((address_space(3)))
typedef unsigned short bf16_t;
typedef short bf16x8 __attribute__((ext_vector_type(8)));
typedef short s16x4 __attribute__((ext_vector_type(4)));
typedef float f32x4 __attribute__((ext_vector_type(4)));
typedef float f32x2 __attribute__((ext_vector_type(2)));
typedef unsigned u32x4 __attribute__((ext_vector_type(4)));
typedef unsigned u32x2 __attribute__((ext_vector_type(2)));
typedef __bf16 bf16x2_t __attribute__((ext_vector_type(2)));
typedef LAS unsigned char lds_t;

DI int lane_id() { return (int)__builtin_amdgcn_mbcnt_hi(~0u, __builtin_amdgcn_mbcnt_lo(~0u, 0u)); }
DI int tid_of(int wave0) { int t = wave0 * 64 + lane_id(); asm volatile("" : "+v"(t)); return t; }
DI unsigned pk(float a, float b) { f32x2 v = {a, b}; bf16x2_t r = __builtin_convertvector(v, bf16x2_t); return __builtin_bit_cast(unsigned, r); }
DI float bflo(unsigned u) { return __uint_as_float(u << 16); }
DI float bfhi(unsigned u) { return __uint_as_float(u & 0xffff0000u); }

constexpr int DM = 1024, NB = 8, SEQ = 2048, DB = 16, DSEQ = 64, PAST = 2048;
constexpr int MP = NB * SEQ;
constexpr int MS = DB * DSEQ;
constexpr int MT = MP + MS;
constexpr int INW = 2816, FF = 4096;
constexpr int NPOS = PAST + DSEQ;
constexpr float EPS = 1e-6f;
constexpr size_t O_Y = 0, O_NKP = 17825792, O_NVP = 17956864, O_NRP = 18087936, O_NKS = 18612224, O_NVS = 18874368, O_NRS = 19136512;
constexpr size_t MiB = 1u << 20;
constexpr size_t WS_CTL = 0, CTL_BYTES = 1 * MiB, WS_ROWSS2 = 1 * MiB + 131072, WS_BAR = 524288, WS_CNT = 262144;
constexpr size_t WS_FLAG = 327680;
constexpr size_t WS_XBUF = 1 * MiB + 524288;
constexpr size_t WS_RS1 = 1 * MiB;
constexpr size_t WS_WIN = 2 * MiB, WS_WOUT = 8 * MiB, WS_WUP = 10 * MiB, WS_WDN = 18 * MiB;
constexpr size_t WS_XN = 26 * MiB;
constexpr size_t WS_MIX = 186 * MiB;
constexpr size_t WS_Z = 60 * MiB;
constexpr size_t WS_US = 154 * MiB;
constexpr size_t WS_SB = 218 * MiB;
constexpr size_t WS_U = 50 * MiB;
constexpr size_t WS_H1B = 220 * MiB;
constexpr size_t WS_SLAB = 186 * MiB;
constexpr int NSPLIT_DN = 8;
constexpr int LDS_BYTES = 147456;
#ifndef WT_STORES
#define WT_STORES 0
#endif

struct Params {
    const float *xp, *xs, *cache_k, *cache_v, *state, *norm1, *w_in, *sinks, *w_out, *norm2, *w_up, *w_down, *norm_f;
    float* out; unsigned char* ws;
};

DI bf16x8 frag_N(const lds_t* base, int rs, int idx0, int k0, int lane) {
    return *(const LAS bf16x8*)(base + (idx0 + (lane & 15)) * rs + (k0 + 8 * (lane >> 4)) * 2);
}
DI s16x4 tr4(const lds_t* a) { return __builtin_amdgcn_ds_read_tr16_b64_v4i16((LAS s16x4*)a); }
DI bf16x8 frag_T(const lds_t* base, int rs, int k0, int idx0, int lane) {
    const int g = lane >> 4, q = (lane >> 2) & 3, p = lane & 3;
    const lds_t* a = base + (k0 + 8 * g + q) * rs + (idx0 + 4 * p) * 2;
    const s16x4 lo = tr4(a), hi = tr4(a + 4 * rs);
    return __builtin_shufflevector(lo, hi, 0, 1, 2, 3, 4, 5, 6, 7);
}
DI bf16x8 frag_Tp(const lds_t* base, int rs, int k0, int idx0, int lane) {
    const int g = lane >> 4, q = (lane >> 2) & 3, p = lane & 3;
    const lds_t* a = base + (k0 + 4 * g + q) * rs + (idx0 + 4 * p) * 2;
    const s16x4 lo = tr4(a), hi = tr4(a + 16 * rs);
    return __builtin_shufflevector(lo, hi, 0, 1, 2, 3, 4, 5, 6, 7);
}
DI f32x4 mfma16(bf16x8 a, bf16x8 b, f32x4 c) { return __builtin_amdgcn_mfma_f32_16x16x32_bf16(a, b, c, 0, 0, 0); }
DI bf16x8 pack8(const f32x4& a, const f32x4& b) { u32x4 w = {pk(a[0], a[1]), pk(a[2], a[3]), pk(b[0], b[1]), pk(b[2], b[3])}; return __builtin_bit_cast(bf16x8, w); }
DI int row_pos(int r) { return r < MP ? (r & (SEQ - 1)) : (PAST + ((r - MP) & (DSEQ - 1))); }

#define XB_TMO      128
#define XB_XCNT(j)  (256  + 64 * (j))
#define XB_XSUB(j)  (1280 + 64 * (j))
#define XB_XGEN(j)  (2304 + 64 * (j))
#define XB_TOP      3328
#define XB_TOPGEN   3392
#define XCD_BAR_WORDS 3456
#define XB_SPIN_CAP (1u << 18)

__device__ __forceinline__ unsigned xb_ld(unsigned* p)              { return __hip_atomic_load(p, __ATOMIC_RELAXED, __HIP_MEMORY_SCOPE_AGENT); }
__device__ __forceinline__ unsigned xb_add(unsigned* p, unsigned v) { return __hip_atomic_fetch_add(p, v, __ATOMIC_RELAXED, __HIP_MEMORY_SCOPE_AGENT); }
__device__ __forceinline__ unsigned xb_xcc_id() { return (unsigned)__builtin_amdgcn_s_getreg((3 << 11) | 20) & 0xFu; }
#define XB_SPIN(cond, bar) do { unsigned _sp = 0; while (cond) { __builtin_amdgcn_s_sleep(1); \
    if ((++_sp & 255u) == 0u) { if (xb_ld(&(bar)[XB_TMO])) break; if (_sp > XB_SPIN_CAP) { atomicAdd(&(bar)[XB_TMO], 1u); break; } } } } while (0)

struct XcdBarrier {
    unsigned* bar; unsigned x; int w0;
    volatile LAS unsigned* st;
};

__device__ __forceinline__ XcdBarrier xcd_barrier_post(unsigned* bar, volatile LAS unsigned* st) {
    XcdBarrier b; b.bar = bar; b.x = xb_xcc_id(); b.st = st;
    if (threadIdx.x == 0) (void)xb_add(&bar[XB_XCNT(b.x)], 1u);
    return b;
}
__device__ __forceinline__ void xcd_barrier_complete(unsigned* bar, unsigned x, unsigned& nloc, unsigned& nx) {
    const unsigned G = gridDim.x * gridDim.y * gridDim.z;
    unsigned sum, cnt, mine, sp = 0u;
    for (;;) {
        sum = 0u; cnt = 0u; mine = 0u;
#pragma unroll
        for (unsigned j = 0; j < 16; ++j) { const unsigned c = xb_ld(&bar[XB_XCNT(j)]); sum += c; cnt += (c > 0u) ? 1u : 0u; mine = (j == x) ? c : mine; }
        if (sum == G) break;
        __builtin_amdgcn_s_sleep(1);
        if ((++sp & 255u) == 0u) { if (xb_ld(&bar[XB_TMO])) break; if (sp > XB_SPIN_CAP) { atomicAdd(&bar[XB_TMO], 1u); break; } }
    }
    nloc = mine > 0u ? mine : 1u; nx = cnt > 0u ? cnt : 1u;
}

__device__ __forceinline__ void xcd_barrier(const XcdBarrier& b) {
    asm volatile("s_waitcnt vmcnt(0)" ::: "memory");
    __syncthreads();
    if (b.w0 == 0 && lane_id() == 0) {
        unsigned* bar = b.bar;
        __builtin_amdgcn_s_waitcnt(0);
        unsigned nloc = b.st[0], nx = b.st[1];
        if (nloc == 0u) { xcd_barrier_complete(bar, b.x, nloc, nx); b.st[0] = nloc; b.st[1] = nx; }
        const unsigned old = xb_add(&bar[XB_XSUB(b.x)], 1u);
        const unsigned gen = old / nloc;
        if (old + 1u == (gen + 1u) * nloc) {
            __builtin_amdgcn_fence(__ATOMIC_RELEASE, "agent");
            asm volatile("s_waitcnt vmcnt(0)" ::: "memory");
            const unsigned og = xb_add(&bar[XB_TOP], 1u);
            const unsigned tg = og / nx;
            if (og + 1u == (tg + 1u) * nx) xb_add(&bar[XB_TOPGEN], 1u);
            else XB_SPIN(xb_ld(&bar[XB_TOPGEN]) == tg, bar);
            __builtin_amdgcn_fence(__ATOMIC_ACQUIRE, "agent");
            xb_add(&bar[XB_XGEN(b.x)], 1u);
            asm volatile("s_waitcnt vmcnt(0)" ::: "memory");
        } else {
            XB_SPIN(xb_ld(&bar[XB_XGEN(b.x)]) == gen, bar);
            __builtin_amdgcn_fence(__ATOMIC_ACQUIRE, "agent");
            asm volatile("s_waitcnt vmcnt(0)" ::: "memory");
        }
    }
    __syncthreads();
}
namespace pg8 {
#define PG8_LAS __attribute__((address_space(3)))
typedef unsigned short bf16_t;
typedef short bf16x8 __attribute__((ext_vector_type(8)));
typedef float f32x4 __attribute__((ext_vector_type(4)));
typedef unsigned u32x4 __attribute__((ext_vector_type(4)));
constexpr int BM = 256, BK = 64, HALF = 128, HTB = HALF * BK * 2  , STAGE_BYTES = 8 * HTB, NXCD = 8, WGM = 8;

__host__ __device__ __forceinline__ int lds_byte(int r, int c) { const int st = (r >> 4) * 2 + (c >> 5), rr = r & 15, cc = c & 31, ob = rr * 64 + cc * 2; return st * 1024 + (ob ^ (((ob >> 9) & 1) << 5)); }
__host__ __device__ __forceinline__ void stage_rc(int b, int& R, int& C) { const int st = b / 1024, sb = b % 1024, swz = sb ^ (((sb >> 9) & 1) << 5); R = (st >> 1) * 16 + swz / 64; C = (st & 1) * 32 + (swz % 64) / 2; }
__host__ __device__ __forceinline__ int perm32(int rho) { const int n = rho >> 4, i = rho & 15; return 8 * (i >> 2) + 4 * n + (i & 3); }

struct Unit { int pm, pn, k0, nt; };
struct Gemm { const bf16_t* A; const bf16_t* Bt; int M, N, K; };

struct StaticOrder {
    int nM, nN, nwg, G, c, ntk;
    __host__ __device__ void init(int M, int N, int K, int G_, int c_) { nM = M / BM; nN = N / BM; nwg = nM * nN; G = G_; c = c_; ntk = K / BK; }
    __host__ __device__ bool next(int i, Unit& u) const { return at((long)i * G + c, u); }
    __host__ __device__ bool at(long L, Unit& u) const {
        if (L >= nwg) return false;
        int wgid = (int)L; { const int q = nwg / NXCD, r = nwg % NXCD, xcd = wgid % NXCD, off = wgid / NXCD; wgid = (xcd < r ? xcd * (q + 1) : r * (q + 1) + (xcd - r) * q) + off; }
        const int nig = WGM * nN, gid = wgid / nig, fm = gid * WGM, gsz = (nM - fm) < WGM ? (nM - fm) : WGM;
        u.pm = fm + ((wgid % nig) % gsz); u.pn = (wgid % nig) / gsz; u.k0 = 0; u.nt = ntk; return true;
    }
    __device__ __forceinline__ void a_ready(const Unit&) const {}
    __device__ __forceinline__ void done(const Unit&) const {}
};


struct TailSplitOrder {
    StaticOrder so; int tailM, nsplit, npieces;
    __host__ __device__ void init(int M, int N, int K, int G_, int c_, int tailM_, int nsplit_) { so.init(M, N, K, G_, c_); tailM = tailM_; nsplit = nsplit_; npieces = tailM_ * so.nN * nsplit_; }
    __host__ __device__ bool next(int i, Unit& u) const {
        const long L = (long)i * so.G + so.c;
        if (L >= npieces) return so.at(L - npieces, u);
        const int p = (int)L, tu = p / nsplit, ks = p % nsplit, nts = so.ntk / nsplit;
        u.pm = so.nM + tu / so.nN; u.pn = tu % so.nN; u.k0 = ks * nts; u.nt = nts; return true;
    }
    __device__ __forceinline__ void a_ready(const Unit&) const {}
    __device__ __forceinline__ void done(const Unit&) const {}
};

struct SubsetOrder {
    int pm0, nN, ntk, cnt, c;
    __host__ __device__ void init(int pm0_, int nN_, int K, int cnt_, int c_) { pm0 = pm0_; nN = nN_; ntk = K / BK; cnt = cnt_; c = c_; }
    __host__ __device__ bool next(int i, Unit& u) const { if (i != 0 || c >= cnt) return false; u.pm = pm0 + c / nN; u.pn = c % nN; u.k0 = 0; u.nt = ntk; return true; }
    __device__ __forceinline__ void a_ready(const Unit&) const {}
    __device__ __forceinline__ void done(const Unit&) const {}
};

DI void st8bf(bf16_t* p, const f32x4& a, const f32x4& b) { u32x4 w = {pk(a[0], a[1]), pk(a[2], a[3]), pk(b[0], b[1]), pk(b[2], b[3])};
#if WT_STORES
    asm volatile("global_store_dwordx4 %0, %1, off sc1\n\ts_nop 1" :: "v"(p), "v"(w) : "memory");
#else
    *(u32x4*)p = w;
#endif
}
struct EpiInProj {
    static constexpr bool PERM = true, AFTER_DRAIN = false, LAST_FUSED = false;
    bf16_t* Z; const float* rowscale; float* out;
    __device__ __forceinline__ void operator()(const f32x4 (&acc)[2][2][4][2], const Unit& u, int wr, int wc, int fr, int fq) const {
        const int pn = u.pn;
        const int kind = pn >= 7 ? 0 : (pn >= 3 ? 1 : ((pn < 2 || wc < 2) ? 2 : 3));
        const int i0 = kind == 1 ? 32 * (wc & 1) + 8 * fq : 8 * fq;
        const int rbase = u.pm * BM + wr * 64 + fr;
        const bool rope = kind == 1 || kind == 2;
        float revf[8];
#pragma unroll
        for (int e = 0; e < 8; ++e) { const float x = kind == 1 ? (float)(i0 + e) * (1.0f / 63.0f) : (float)(i0 + e) * (1.0f / 32.0f); revf[e] = exp2f(-x * 13.287712379549449f) * 0.15915494309189535f; }
        float rsv[8];
#pragma unroll
        for (int idx = 0; idx < 8; ++idx) rsv[idx] = rowscale[rbase + (idx >> 2) * HALF + (idx & 3) * 16];
        f32x4 cd0, sd0, cd1, sd1;
        if (rope) {
#pragma unroll
            for (int e = 0; e < 4; ++e) {
                const float f0 = __builtin_amdgcn_fractf(16.0f * revf[e]), f1 = __builtin_amdgcn_fractf(16.0f * revf[4 + e]);
                cd0[e] = __builtin_amdgcn_cosf(f0); sd0[e] = __builtin_amdgcn_sinf(f0); cd1[e] = __builtin_amdgcn_cosf(f1); sd1[e] = __builtin_amdgcn_sinf(f1);
            }
        }
        f32x4 c0, s0, c1, s1;
#pragma unroll
        for (int idx = 0; idx < 8; ++idx) {
            const int ai = idx >> 2, m = idx & 3;
            const int r = rbase + ai * HALF + m * 16;
            const float rs = rsv[idx];
            f32x4 x1a = acc[ai][0][m][0] * rs, x1b = acc[ai][0][m][1] * rs, x2a = acc[ai][1][m][0] * rs, x2b = acc[ai][1][m][1] * rs;
            if (rope) {
                if (m == 0) {
                    const float posf = (float)row_pos(r);
#pragma unroll
                    for (int e = 0; e < 4; ++e) {
                        const float f0 = __builtin_amdgcn_fractf(posf * revf[e]), f1 = __builtin_amdgcn_fractf(posf * revf[4 + e]);
                        c0[e] = __builtin_amdgcn_cosf(f0); s0[e] = __builtin_amdgcn_sinf(f0); c1[e] = __builtin_amdgcn_cosf(f1); s1[e] = __builtin_amdgcn_sinf(f1);
                    }
                } else {
                    const f32x4 nc0 = c0 * cd0 - s0 * sd0, ns0 = s0 * cd0 + c0 * sd0, nc1 = c1 * cd1 - s1 * sd1, ns1 = s1 * cd1 + c1 * sd1;
                    c0 = nc0; s0 = ns0; c1 = nc1; s1 = ns1;
                }
                const f32x4 o1a = x1a * c0 - x2a * s0, o2a = x2a * c0 + x1a * s0, o1b = x1b * c1 - x2b * s1, o2b = x2b * c1 + x1b * s1;
                x1a = o1a; x2a = o2a; x1b = o1b; x2b = o2b;
            }
            bf16_t* zr = Z + (size_t)r * INW;
            if (kind == 0) {
                const int c = pn * 256 + wc * 64 + 8 * fq;
                st8bf(zr + c, x1a, x1b); st8bf(zr + c + 32, x2a, x2b);
            } else if (kind == 1) {
                const int cb = pn * 256 + 128 * (wc >> 1) + i0;
                st8bf(zr + cb, x1a, x1b); st8bf(zr + cb + 64, x2a, x2b);
            } else if (kind == 2) {
                const int cb = (pn < 2 ? pn * 256 : 512) + 64 * wc + i0;
                st8bf(zr + cb, x1a, x1b); st8bf(zr + cb + 32, x2a, x2b);
                if (pn == 2) {
                    float* o = nullptr;
                    if (r < MP) { const int t = r & (SEQ - 1); if (t >= SEQ - 128) o = out + O_NKP + ((size_t)((r >> 11) * 128 + (t - (SEQ - 128))) * 2 + wc) * 64 + i0; }
                    else { const int q = r - MP; o = out + O_NKS + ((size_t)((q >> 6) * 128 + 64 + (q & 63)) * 2 + wc) * 64 + i0; }
                    if (o) { *(f32x4*)o = x1a; *(f32x4*)(o + 4) = x1b; *(f32x4*)(o + 32) = x2a; *(f32x4*)(o + 36) = x2b; }
                }
            } else {
                const int d0 = 8 * fq, kvh = wc - 2;
                st8bf(zr + 640 + 64 * kvh + d0, x1a, x1b); st8bf(zr + 640 + 64 * kvh + 32 + d0, x2a, x2b);
                float* o = nullptr;
                if (r < MP) { const int t = r & (SEQ - 1); if (t >= SEQ - 128) o = out + O_NVP + ((size_t)((r >> 11) * 128 + (t - (SEQ - 128))) * 2 + kvh) * 64 + d0; }
                else { const int q = r - MP; o = out + O_NVS + ((size_t)((q >> 6) * 128 + 64 + (q & 63)) * 2 + kvh) * 64 + d0; }
                if (o) { *(f32x4*)o = x1a; *(f32x4*)(o + 4) = x1b; *(f32x4*)(o + 32) = x2a; *(f32x4*)(o + 36) = x2b; }
            }
        }
    }
};
struct EpiOutProj {
    static constexpr bool PERM = true, AFTER_DRAIN = false, LAST_FUSED = false;
    const bf16_t* xn; bf16_t* h1b; float* rowss;
    __device__ __forceinline__ void operator()(const f32x4 (&acc)[2][2][4][2], const Unit& u, int wr, int wc, int fr, int fq) const {
        const int rbase = u.pm * BM + wr * 64 + fr, cbase = u.pn * BM + wc * 64 + 8 * fq;
#pragma unroll
        for (int idx = 0; idx < 8; ++idx) {
            const int ai = idx >> 2, m = idx & 3, r = rbase + ai * HALF + m * 16;
            float ss = 0.f;
#pragma unroll
            for (int bj = 0; bj < 2; ++bj) {
                const u32x4 xb = *(const u32x4*)(xn + (size_t)r * DM + cbase + bj * 32);
                const f32x4 h0 = (f32x4){bflo(xb.x), bfhi(xb.x), bflo(xb.y), bfhi(xb.y)} + acc[ai][bj][m][0], h1 = (f32x4){bflo(xb.z), bfhi(xb.z), bflo(xb.w), bfhi(xb.w)} + acc[ai][bj][m][1];
                ss += ((h0[0] * h0[0] + h0[1] * h0[1]) + (h0[2] * h0[2] + h0[3] * h0[3])) + ((h1[0] * h1[0] + h1[1] * h1[1]) + (h1[2] * h1[2] + h1[3] * h1[3]));
                st8bf(h1b + (size_t)r * DM + cbase + bj * 32, h0, h1);
            }
            ss += __shfl_xor(ss, 16); ss += __shfl_xor(ss, 32);
            if (fq == 0) unsafeAtomicAdd(rowss + (size_t)r * 4 + u.pn, ss);
        }
    }
};
struct EpiOutProjDma {
    static constexpr bool PERM = true, AFTER_DRAIN = true, LAST_FUSED = false;
    const bf16_t* xn; bf16_t* h1b; float* rowss;
    __device__ __forceinline__ void fused(f32x4 (&acc)[2][2][4][2], const Unit& u, int wr, int wc, int fr, int fq, PG8_LAS unsigned char* lds, int wid, int lane) const {
        const int cbase = u.pn * BM + wc * 64 + 8 * fq;
        PG8_LAS float* red = (PG8_LAS float*)(lds + 131072 + 1024);
#pragma unroll
        for (int j = 0; j < 16; ++j) {
            const int rA = wid * 32 + 2 * j, rl = rA + (lane >> 5), chunk = ((lane & 31) + rl) & 31;
            const bf16_t* src = xn + (size_t)(u.pm * BM + rl) * DM + u.pn * BM + chunk * 8;
            __builtin_amdgcn_global_load_lds((const unsigned*)src, (PG8_LAS unsigned*)(lds + rA * 512), 16, 0, 2);
        }
        asm volatile("s_waitcnt vmcnt(0)" ::: "memory"); __builtin_amdgcn_s_barrier(); asm volatile("" ::: "memory");
#pragma unroll
        for (int ai = 0; ai < 2; ++ai) {
#pragma unroll
            for (int m = 0; m < 4; ++m) {
                const int rl = ai * HALF + wr * 64 + m * 16 + fr, r = u.pm * BM + rl;
                float ss = 0.f;
#pragma unroll
                for (int bj = 0; bj < 2; ++bj) {
                    const int pos = (wc * 8 + bj * 4 + fq - rl) & 31;
                    const u32x4 xb = *(const PG8_LAS u32x4*)(lds + rl * 512 + pos * 16);
                    const f32x4 h0 = (f32x4){bflo(xb.x), bfhi(xb.x), bflo(xb.y), bfhi(xb.y)} + acc[ai][bj][m][0], h1 = (f32x4){bflo(xb.z), bfhi(xb.z), bflo(xb.w), bfhi(xb.w)} + acc[ai][bj][m][1];
                    ss += ((h0[0] * h0[0] + h0[1] * h0[1]) + (h0[2] * h0[2] + h0[3] * h0[3])) + ((h1[0] * h1[0] + h1[1] * h1[1]) + (h1[2] * h1[2] + h1[3] * h1[3]));
                    st8bf(h1b + (size_t)r * DM + cbase + bj * 32, h0, h1);
                }
                ss += __shfl_xor(ss, 16); ss += __shfl_xor(ss, 32);
                if (fq == 0) red[(wr * 64 + m * 16 + fr) * 4 + wc] = ss;
            }
            asm volatile("s_waitcnt lgkmcnt(0)" ::: "memory"); __builtin_amdgcn_s_barrier(); asm volatile("" ::: "memory");
            { const int t = wid * 64 + lane; if (t < HALF) rowss[(size_t)(u.pm * BM + ai * HALF + t) * 4 + u.pn] = (red[t * 4] + red[t * 4 + 1]) + (red[t * 4 + 2] + red[t * 4 + 3]); }
            asm volatile("s_waitcnt lgkmcnt(0)" ::: "memory"); __builtin_amdgcn_s_barrier(); asm volatile("" ::: "memory");
        }
    }
};
struct EpiUp {
    static constexpr bool PERM = true, AFTER_DRAIN = false, LAST_FUSED = false;
    const float* rowss; bf16_t* U;
    __device__ __forceinline__ void operator()(const f32x4 (&acc)[2][2][4][2], const Unit& u, int wr, int wc, int fr, int fq) const {
        float rsv[8];
#pragma unroll
        for (int idx = 0; idx < 8; ++idx) { const f32x4 q = *(const f32x4*)(rowss + (size_t)(u.pm * BM + (idx >> 2) * HALF + wr * 64 + (idx & 3) * 16 + fr) * 4); rsv[idx] = (q[0] + q[1]) + (q[2] + q[3]); }
#pragma unroll
        for (int ai = 0; ai < 2; ++ai)
#pragma unroll
            for (int m = 0; m < 4; ++m) {
                const int r = u.pm * BM + ai * HALF + wr * 64 + m * 16 + fr;
                const float rs = rsqrtf(rsv[ai * 4 + m] * (1.0f / DM) + EPS);
#pragma unroll
                for (int bj = 0; bj < 2; ++bj) {
                    f32x4 a = acc[ai][bj][m][0] * rs, b = acc[ai][bj][m][1] * rs;
#pragma unroll
                    for (int t = 0; t < 4; ++t) { a[t] = fmaxf(a[t], 0.f); a[t] *= a[t]; b[t] = fmaxf(b[t], 0.f); b[t] *= b[t]; }
                    st8bf(U + (size_t)r * FF + u.pn * BM + wc * 64 + bj * 32 + 8 * fq, a, b);
                }
            }
    }
};
struct EpiDownNorm {
    static constexpr bool PERM = true, AFTER_DRAIN = false, LAST_FUSED = true;
    const bf16_t* h1b; float* y; bf16_t* slab; const float* normf; float* xbuf; unsigned* cnt;
    __device__ __forceinline__ void operator()(f32x4 (&acc)[2][2][4][2], const Unit& u, int wr, int wc, int fr, int fq) const {
#pragma unroll
        for (int ai = 0; ai < 2; ++ai)
#pragma unroll
            for (int m = 0; m < 4; ++m) {
                const int r = u.pm * BM + ai * HALF + wr * 64 + m * 16 + fr;
#pragma unroll
                for (int bj = 0; bj < 2; ++bj)
                    st8bf(slab + (size_t)(u.k0 / u.nt) * ((size_t)MS * DM) + (size_t)(r - MP) * DM + u.pn * BM + wc * 64 + bj * 32 + 8 * fq, acc[ai][bj][m][0], acc[ai][bj][m][1]);
            }
    }
    __device__ __forceinline__ void fused(f32x4 (&acc)[2][2][4][2], const Unit& u, int wr, int wc, int fr, int fq, PG8_LAS unsigned char* lds, int wid, int lane) const {
        if (u.nt != FF / BK) { (*this)(acc, u, wr, wc, fr, fq); return; }
        PG8_LAS float* Pp = (PG8_LAS float*)(lds + 131072 + 1024); PG8_LAS float* Sr = (PG8_LAS float*)(lds + 131072 + 1024 + 4096);
        const int tid = wid * 64 + lane;
#pragma unroll
        for (int j = 0; j < 16; ++j) {
            const int rA = wid * 32 + 2 * j, rl = rA + (lane >> 5), chunk = ((lane & 31) + rl) & 31;
            const bf16_t* src = h1b + (size_t)(u.pm * BM + rl) * DM + u.pn * BM + chunk * 8;
            __builtin_amdgcn_global_load_lds((const unsigned*)src, (PG8_LAS unsigned*)(lds + rA * 512), 16, 0, 2);
        }
        asm volatile("s_waitcnt vmcnt(0)" ::: "memory"); __builtin_amdgcn_s_barrier(); asm volatile("" ::: "memory");
#pragma unroll
        for (int ai = 0; ai < 2; ++ai)
#pragma unroll
            for (int m = 0; m < 4; ++m) {
                const int rl = ai * HALF + wr * 64 + m * 16 + fr;
                float ss = 0.f;
#pragma unroll
                for (int bj = 0; bj < 2; ++bj) {
                    const int pos = (wc * 8 + bj * 4 + fq - rl) & 31;
                    const u32x4 xb = *(const PG8_LAS u32x4*)(lds + rl * 512 + pos * 16);
                    const f32x4 h0 = acc[ai][bj][m][0] + (f32x4){bflo(xb.x), bfhi(xb.x), bflo(xb.y), bfhi(xb.y)}, h1 = acc[ai][bj][m][1] + (f32x4){bflo(xb.z), bfhi(xb.z), bflo(xb.w), bfhi(xb.w)};
                    acc[ai][bj][m][0] = h0; acc[ai][bj][m][1] = h1;
                    ss += ((h0[0] * h0[0] + h0[1] * h0[1]) + (h0[2] * h0[2] + h0[3] * h0[3])) + ((h1[0] * h1[0] + h1[1] * h1[1]) + (h1[2] * h1[2] + h1[3] * h1[3]));
                }
                ss += __shfl_xor(ss, 16); ss += __shfl_xor(ss, 32);
                if (fq == 0) Pp[rl * 4 + wc] = ss;
            }
        asm volatile("s_waitcnt lgkmcnt(0)" ::: "memory"); __builtin_amdgcn_s_barrier(); asm volatile("" ::: "memory");
        if (tid < 256) {
            const float t = (Pp[tid * 4] + Pp[tid * 4 + 1]) + (Pp[tid * 4 + 2] + Pp[tid * 4 + 3]);
            __hip_atomic_store(xbuf + ((size_t)(u.pm * BM + tid) * 4 + u.pn), t, __ATOMIC_RELAXED, __HIP_MEMORY_SCOPE_AGENT);
        }
        asm volatile("s_waitcnt vmcnt(0)" ::: "memory");
        __builtin_amdgcn_s_barrier(); asm volatile("" ::: "memory");
        if (tid == 0) {
            unsigned* cw = cnt + 64 * u.pm;
            __hip_atomic_fetch_add(cw, 1u, __ATOMIC_RELAXED, __HIP_MEMORY_SCOPE_AGENT);
            unsigned sp = 0;
            while (__hip_atomic_load(cw, __ATOMIC_RELAXED, __HIP_MEMORY_SCOPE_AGENT) < 4u) { __builtin_amdgcn_s_sleep(2); if (++sp > (1u << 20)) break; }
            __builtin_amdgcn_fence(__ATOMIC_ACQUIRE, "agent");
        }
        asm volatile("s_waitcnt vmcnt(0) lgkmcnt(0)" ::: "memory"); __builtin_amdgcn_s_barrier(); asm volatile("" ::: "memory");
        if (tid < 256) {
            const float* slot = xbuf + (size_t)(u.pm * BM + tid) * 4;
            const float t = (__hip_atomic_load(slot, __ATOMIC_RELAXED, __HIP_MEMORY_SCOPE_AGENT) + __hip_atomic_load(slot + 1, __ATOMIC_RELAXED, __HIP_MEMORY_SCOPE_AGENT))
                          + (__hip_atomic_load(slot + 2, __ATOMIC_RELAXED, __HIP_MEMORY_SCOPE_AGENT) + __hip_atomic_load(slot + 3, __ATOMIC_RELAXED, __HIP_MEMORY_SCOPE_AGENT));
            Sr[tid] = rsqrtf(t * (1.0f / DM) + EPS);
        }
        asm volatile("s_waitcnt lgkmcnt(0)" ::: "memory"); __builtin_amdgcn_s_barrier(); asm volatile("" ::: "memory");
        f32x4 nf[2][2];
#pragma unroll
        for (int bj = 0; bj < 2; ++bj)
#pragma unroll
            for (int n = 0; n < 2; ++n) nf[bj][n] = *(const f32x4*)(normf + u.pn * BM + wc * 64 + bj * 32 + n * 4 + 8 * fq);
#pragma unroll
        for (int ai = 0; ai < 2; ++ai)
#pragma unroll
            for (int m = 0; m < 4; ++m) {
                const int rl = ai * HALF + wr * 64 + m * 16 + fr; const size_t row = (size_t)(u.pm * BM + rl);
                const float rs = Sr[rl];
#pragma unroll
                for (int bj = 0; bj < 2; ++bj)
#pragma unroll
                    for (int n = 0; n < 2; ++n)
                        *(f32x4*)(y + row * DM + u.pn * BM + wc * 64 + bj * 32 + n * 4 + 8 * fq) = acc[ai][bj][m][n] * rs * nf[bj][n];
            }
    }
};
template <class Epi, class Sched, bool ALIGN_EPI = false, bool SP2 = false, int AUXA = 0>
__device__ __forceinline__ void gemm_phase(PG8_LAS unsigned char* lds, const Gemm g, const Sched& S, const Epi& E, int wave0) {
    const int tid = tid_of(wave0), wid = wave0, lane = tid & 63, wr = wid >> 2, wc = wid & 3, fr = lane & 15, fq = lane >> 4;
    const int K = g.K;
    unsigned voffA[2], voffB[2];
#pragma unroll
    for (int i = 0; i < 2; ++i) { int R, C; stage_rc(tid * 16 + i * 8192, R, C); const int Rb = (R >> 5) * 64 + (Epi::PERM ? perm32(R & 31) : (R & 31));
        voffA[i] = (unsigned)(R * K + C) * 2u; voffB[i] = (unsigned)(Rb * K + C) * 2u; }
    const size_t kstep = (size_t)(BK * 2);
    const size_t hstep = (size_t)HALF * K * 2;
    const size_t tstep = 2 * hstep;
    const size_t hstepB = (size_t)32 * K * 2;
    const unsigned ldsw = (unsigned)wid * 1024u;
    const int aoff = lds_byte(wr * 64 + fr, fq * 8), boff = lds_byte(wc * 32 + fr, fq * 8);
#define PG8_SA(b, h) (((b) * 2 + (h)) * HTB)
#define PG8_SB(b, h) ((4 + (b) * 2 + (h)) * HTB)
#define PG8_STAGE(bufoff, gbase, voff) do { _Pragma("unroll") for (int _i = 0; _i < 2; ++_i) \
        __builtin_amdgcn_global_load_lds((const unsigned*)((const char*)(gbase) + (voff)[_i]), (PG8_LAS unsigned*)(lds + (bufoff) + ldsw + _i * 8192), 16, 0, 0); } while (0)
#define PG8_STAGEA(bufoff, gbase, voff) do { _Pragma("unroll") for (int _i = 0; _i < 2; ++_i) \
        __builtin_amdgcn_global_load_lds((const unsigned*)((const char*)(gbase) + (voff)[_i]), (PG8_LAS unsigned*)(lds + (bufoff) + ldsw + _i * 8192), 16, 0, AUXA); } while (0)
#define PG8_LDA(dst, b, h) do { _Pragma("unroll") for (int m = 0; m < 4; ++m) _Pragma("unroll") for (int k = 0; k < 2; ++k) dst[m][k] = *(const PG8_LAS bf16x8*)(lds + PG8_SA(b, h) + aoff + m * 2048 + k * 1024); } while (0)
#define PG8_LDB(dst, b, h) do { _Pragma("unroll") for (int n = 0; n < 2; ++n) _Pragma("unroll") for (int k = 0; k < 2; ++k) dst[n][k] = *(const PG8_LAS bf16x8*)(lds + PG8_SB(b, h) + boff + n * 2048 + k * 1024); } while (0)
#define PG8_MMA(ai, bj, At, Bt) do { __builtin_amdgcn_s_setprio(1); _Pragma("unroll") for (int m = 0; m < 4; ++m) _Pragma("unroll") for (int n = 0; n < 2; ++n) _Pragma("unroll") for (int k = 0; k < 2; ++k) \
        acc[ai][bj][m][n] = __builtin_amdgcn_mfma_f32_16x16x32_bf16(Bt[n][k], At[m][k], acc[ai][bj][m][n], 0, 0, 0); __builtin_amdgcn_s_setprio(0); } while (0)
#define PG8_WAIT_V(n) asm volatile("s_waitcnt vmcnt(" #n ")" ::: "memory")
#define PG8_WAIT_L(n) asm volatile("s_waitcnt lgkmcnt(" #n ")" ::: "memory")
#define PG8_BAR __builtin_amdgcn_s_barrier()
#define PG8_SCHED __builtin_amdgcn_sched_barrier(0)
    Unit cur, nxt; int ui = 0;
    if (!S.next(0, cur)) return;
    f32x4 acc[2][2][4][2];
#pragma unroll
    for (int a = 0; a < 2; ++a)
#pragma unroll
        for (int b = 0; b < 2; ++b)
#pragma unroll
            for (int m = 0; m < 4; ++m)
#pragma unroll
                for (int n = 0; n < 2; ++n) acc[a][b][m][n] = (f32x4){0.f, 0.f, 0.f, 0.f};
    bf16x8 At[4][2], B0[2][2], B1[2][2];
    const char* cA = (const char*)g.A + (size_t)cur.pm * tstep + (size_t)cur.k0 * (BK * 2); const char* cB = (const char*)g.Bt + (size_t)cur.pn * tstep + (size_t)cur.k0 * (BK * 2);
    S.a_ready(cur);
    if constexpr (SP2) {
        PG8_STAGE(PG8_SB(0, 0), cB, voffB); PG8_STAGE(PG8_SB(0, 1), cB + hstepB, voffB); PG8_STAGEA(PG8_SA(0, 0), cA, voffA); PG8_STAGEA(PG8_SA(0, 1), cA + hstep, voffA);
        if (wr == 1) PG8_BAR;
        PG8_WAIT_V(2); PG8_BAR;
        PG8_STAGE(PG8_SB(1, 0), cB + kstep, voffB); PG8_STAGEA(PG8_SA(1, 0), cA + kstep, voffA); PG8_STAGE(PG8_SB(1, 1), cB + hstepB + kstep, voffB);
        PG8_WAIT_V(6); PG8_BAR;
    } else {
        PG8_STAGE(PG8_SB(0, 0), cB, voffB); PG8_STAGEA(PG8_SA(0, 0), cA, voffA); PG8_STAGE(PG8_SB(0, 1), cB + hstepB, voffB); PG8_STAGEA(PG8_SA(0, 1), cA + hstep, voffA);
        if (wr == 1) PG8_BAR;
        PG8_WAIT_V(4); PG8_BAR;
        PG8_STAGE(PG8_SB(1, 0), cB + kstep, voffB); PG8_STAGEA(PG8_SA(1, 0), cA + kstep, voffA); PG8_STAGE(PG8_SB(1, 1), cB + hstepB + kstep, voffB);
        PG8_WAIT_V(6); PG8_BAR;
    }
    for (;;) {
        const bool has_next = S.next(ui + 1, nxt);
        const char* nA = has_next ? (const char*)g.A + (size_t)nxt.pm * tstep + (size_t)nxt.k0 * (BK * 2) : cA; const char* nB = has_next ? (const char*)g.Bt + (size_t)nxt.pn * tstep + (size_t)nxt.k0 * (BK * 2) : cB;
        const int nt = cur.nt;
        for (int t = 0; t < nt; t += 2) {
            const bool last = (t == nt - 2);
            const char* a1 = cA + (size_t)(t + 1) * kstep;
            const char* a2 = last ? nA : cA + (size_t)(t + 2) * kstep; const char* b2 = last ? nB : cB + (size_t)(t + 2) * kstep;
            const char* a3 = a2 + kstep; const char* b3 = b2 + kstep;
            if (last && has_next) S.a_ready(nxt);
            if constexpr (SP2) {
            PG8_LDB(B0, 0, 0); PG8_LDB(B1, 0, 1); PG8_SCHED; PG8_LDA(At, 0, 0); PG8_STAGEA(PG8_SA(1, 1), a1 + hstep, voffA);
            PG8_WAIT_V(8); PG8_WAIT_L(0); PG8_BAR; PG8_MMA(0, 0, At, B0); PG8_MMA(0, 1, At, B1); PG8_BAR; PG8_SCHED;
            PG8_LDA(At, 0, 1); PG8_STAGE(PG8_SB(0, 0), b2, voffB); PG8_STAGE(PG8_SB(0, 1), b2 + hstepB, voffB); PG8_STAGEA(PG8_SA(0, 0), a2, voffA);
            PG8_WAIT_V(8); PG8_WAIT_L(0); PG8_BAR; PG8_MMA(1, 0, At, B0); PG8_MMA(1, 1, At, B1); PG8_BAR; PG8_SCHED;
            PG8_LDB(B0, 1, 0); PG8_LDB(B1, 1, 1); PG8_SCHED; PG8_LDA(At, 1, 0); PG8_STAGEA(PG8_SA(0, 1), a2 + hstep, voffA);
            PG8_WAIT_V(8); PG8_WAIT_L(0); PG8_BAR; PG8_MMA(0, 0, At, B0); PG8_MMA(0, 1, At, B1); PG8_BAR; PG8_SCHED;
            PG8_LDA(At, 1, 1); PG8_STAGE(PG8_SB(1, 0), b3, voffB); PG8_STAGE(PG8_SB(1, 1), b3 + hstepB, voffB); PG8_STAGEA(PG8_SA(1, 0), a3, voffA);
            PG8_WAIT_V(8); PG8_WAIT_L(0); PG8_BAR; PG8_MMA(1, 0, At, B0); PG8_MMA(1, 1, At, B1); PG8_BAR; PG8_SCHED;
            } else {
            PG8_LDB(B0, 0, 0); PG8_SCHED; PG8_LDA(At, 0, 0); PG8_STAGEA(PG8_SA(1, 1), a1 + hstep, voffA);
            PG8_WAIT_L(8); PG8_BAR; PG8_WAIT_L(0); PG8_MMA(0, 0, At, B0); PG8_BAR; PG8_SCHED;
            PG8_LDB(B1, 0, 1); PG8_STAGE(PG8_SB(0, 0), b2, voffB);
            PG8_BAR; PG8_WAIT_L(0); PG8_MMA(0, 1, At, B1); PG8_BAR;
            PG8_LDA(At, 0, 1); PG8_STAGEA(PG8_SA(0, 0), a2, voffA);
            PG8_BAR; PG8_WAIT_L(0); PG8_MMA(1, 0, At, B0); PG8_BAR; PG8_SCHED;
            PG8_STAGE(PG8_SB(0, 1), b2 + hstepB, voffB);
            PG8_WAIT_V(6); PG8_BAR; PG8_MMA(1, 1, At, B1); PG8_BAR;
            PG8_LDB(B0, 1, 0); PG8_SCHED; PG8_LDA(At, 1, 0); PG8_STAGEA(PG8_SA(0, 1), a2 + hstep, voffA);
            PG8_WAIT_L(8); PG8_BAR; PG8_WAIT_L(0); PG8_MMA(0, 0, At, B0); PG8_BAR; PG8_SCHED;
            PG8_LDB(B1, 1, 1); PG8_STAGE(PG8_SB(1, 0), b3, voffB);
            PG8_BAR; PG8_WAIT_L(0); PG8_MMA(0, 1, At, B1); PG8_BAR;
            PG8_LDA(At, 1, 1); PG8_STAGEA(PG8_SA(1, 0), a3, voffA);
            PG8_BAR; PG8_WAIT_L(0); PG8_MMA(1, 0, At, B0); PG8_BAR; PG8_SCHED;
            PG8_STAGE(PG8_SB(1, 1), b3 + hstepB, voffB);
            PG8_WAIT_V(6); PG8_BAR; PG8_MMA(1, 1, At, B1); PG8_BAR;
            }
        }
        if constexpr (ALIGN_EPI) { if (wr == 0) PG8_BAR; }
        if constexpr (!Epi::AFTER_DRAIN) { if (!(Epi::LAST_FUSED && !has_next)) { E(acc, cur, wr, wc, fr, fq); S.done(cur); } }
        if (!has_next) break;
#pragma unroll
        for (int a = 0; a < 2; ++a)
#pragma unroll
            for (int b = 0; b < 2; ++b)
#pragma unroll
                for (int m = 0; m < 4; ++m)
#pragma unroll
                    for (int n = 0; n < 2; ++n) acc[a][b][m][n] = (f32x4){0.f, 0.f, 0.f, 0.f};
        cur = nxt; cA = nA; cB = nB; ++ui;
        if constexpr (ALIGN_EPI) { if (wr == 1) PG8_BAR; }
    }
    PG8_WAIT_V(0);
    if constexpr (!ALIGN_EPI) { if (wr == 0) PG8_BAR; }
    PG8_BAR;
    if constexpr (Epi::AFTER_DRAIN || Epi::LAST_FUSED) { E.fused(acc, cur, wr, wc, fr, fq, lds, wid, lane); S.done(cur); }
#undef PG8_SA
#undef PG8_SB
#undef PG8_STAGE
#undef PG8_STAGEA
#undef PG8_LDA
#undef PG8_LDB
#undef PG8_MMA
#undef PG8_WAIT_V
#undef PG8_WAIT_L
#undef PG8_BAR
#undef PG8_SCHED
}
}

DI void st8(bf16_t* p, u32x2 w, bool wt) {
    if (wt) __hip_atomic_store((unsigned long long*)p, ((unsigned long long)w.y << 32) | w.x, __ATOMIC_RELAXED, __HIP_MEMORY_SCOPE_AGENT);
    else *(u32x2*)p = w;
}
DI float wave_sum(float v) {
#pragma unroll
    for (int o = 1; o < 64; o <<= 1) v += __shfl_xor(v, o);
    return v;
}
DI int win_perm(int n) {
    if (n >= 768 && n < 1792) { const int r = n & 255, hl = r >> 7, half = (r >> 6) & 1, q = (r >> 5) & 1; return (n & ~255) + 64 * (2 * hl + q) + 32 * half + (r & 31); }
    return n;
}
DI void p0_transpose_item(const float* W, int K, int N, bf16_t* WT, const float* gain, bool is_win, LAS float* scr, int item, int lane) {
    const int nblk = N / 32, kb = item / nblk, nb = item % nblk, k0 = 64 * kb, n0 = 32 * nb;
    float cs = 1.f; int prow = n0;
    if (is_win) { prow = win_perm(n0); if (n0 < 512) cs = 0.125f; else if (n0 >= 1280 && n0 < 1792) cs = 0.08838834764831845f; }
#pragma unroll 8
    for (int i = 0; i < 32; ++i) { const int kk = 2 * i + (lane >> 5); float w = __builtin_nontemporal_load(W + (size_t)(k0 + kk) * N + n0 + (lane & 31)) * cs;     if (gain) w *= gain[k0 + kk]; scr[kk * 33 + (lane & 31)] = w; }
    asm volatile("s_waitcnt lgkmcnt(0)" ::: "memory");
    const int c = lane & 7;
#pragma unroll
    for (int j = 0; j < 4; ++j) { const int n = (lane >> 3) + 8 * j; const LAS float* s = scr + (8 * c) * 33 + n;
        u32x4 o; o.x = pk(s[0 * 33], s[1 * 33]); o.y = pk(s[2 * 33], s[3 * 33]); o.z = pk(s[4 * 33], s[5 * 33]); o.w = pk(s[6 * 33], s[7 * 33]);
        *(u32x4*)(WT + (size_t)(prow + n) * K + k0 + 8 * c) = o; }
    asm volatile("s_waitcnt lgkmcnt(0)" ::: "memory");
}
DI void p0_prologue(const Params& P, lds_t* lds, int G, int tid, int wave, int lane, bool late_ffn) {
    unsigned char* ws = P.ws;
    LAS float* scr = (LAS float*)(lds + wave * 16384);
    const int gw = blockIdx.x * 8 + wave, NGW = G * 8;
    constexpr int I_IN = (DM / 64) * (INW / 32), I_OUT = (DM / 64) * (DM / 32), I_UP = (DM / 64) * (FF / 32), I_DN = (FF / 64) * (DM / 32);
    const int n_items = late_ffn ? I_IN + I_OUT : I_IN + I_OUT + I_UP + I_DN;
    for (int it = gw; it < n_items; it += NGW) {
        int r = it;
        if (r < I_IN) { p0_transpose_item(P.w_in, DM, INW, (bf16_t*)(ws + WS_WIN), P.norm1, true, scr, r, lane); continue; } r -= I_IN;
        if (r < I_OUT) { p0_transpose_item(P.w_out, DM, DM, (bf16_t*)(ws + WS_WOUT), nullptr, false, scr, r, lane); continue; } r -= I_OUT;
        if (r < I_UP) { p0_transpose_item(P.w_up, DM, FF, (bf16_t*)(ws + WS_WUP), P.norm2, false, scr, r, lane); continue; } r -= I_UP;
        p0_transpose_item(P.w_down, FF, DM, (bf16_t*)(ws + WS_WDN), nullptr, false, scr, r, lane);
    }
    bf16_t* XN = (bf16_t*)(ws + WS_XN); float* rs1 = (float*)(ws + WS_RS1);
    for (int m = gw; m < MT; m += NGW) {
        const float* xr = m < MP ? P.xp + (size_t)m * DM : P.xs + (size_t)(m - MP) * DM;
        f32x4 v[4]; float s = 0.f;
#pragma unroll
        for (int j = 0; j < 4; ++j) { v[j] = __builtin_nontemporal_load((const f32x4*)(xr + 4 * lane + 256 * j)); s += (v[j][0] * v[j][0] + v[j][1] * v[j][1]) + (v[j][2] * v[j][2] + v[j][3] * v[j][3]); }
        s = wave_sum(s);
        if (lane == 0) rs1[m] = rsqrtf(s * (1.0f / DM) + EPS);
#pragma unroll
        for (int j = 0; j < 4; ++j) { u32x2 w = {pk(v[j][0], v[j][1]), pk(v[j][2], v[j][3])}; *(u32x2*)(XN + (size_t)m * DM + 4 * lane + 256 * j) = w; }
    }
    const int gt = blockIdx.x * 512 + tid, NGT = G * 512;
    for (int e = gt; e < MT * 4; e += NGT) ((float*)(ws + WS_ROWSS2))[e] = 0.f;
    for (int e = gt; e < 2 * DB * 2048; e += NGT) {
        const int which = e / (DB * 2048), q = e % (DB * 2048), b = q >> 11, o4 = (q & 2047) * 4;
        const float* src = (which ? P.cache_v : P.cache_k) + (size_t)b * 16384 + 8192 + o4;
        float* dst = P.out + (which ? O_NVS : O_NKS) + (size_t)b * 16384 + o4;
        *(f32x4*)dst = __builtin_nontemporal_load((const f32x4*)src);
    }
}

DI void p2_ffn_weights(const Params& P, lds_t* lds, int GP, int bx, int wave, int lane) {
    unsigned char* ws = P.ws;
    LAS float* scr = (LAS float*)(lds + wave * 16384);
    constexpr int I_UP = (DM / 64) * (FF / 32), I_DN = (FF / 64) * (DM / 32);
    for (int it = bx * 8 + wave; it < I_UP + I_DN; it += GP * 8) {
        if (it < I_UP) p0_transpose_item(P.w_up, DM, FF, (bf16_t*)(ws + WS_WUP), P.norm2, false, scr, it, lane);
        else p0_transpose_item(P.w_down, FF, DM, (bf16_t*)(ws + WS_WDN), nullptr, false, scr, it - I_UP, lane);
    }
}

DI void attn_decode(int unit, bool& samp, int& b, int& kvh, int& c) {
    samp = unit >= 512;
    if (!samp) { b = unit >> 6; kvh = (unit >> 5) & 1; c = unit & 31; } else { const int u2 = unit - 512; b = u2 >> 1; kvh = u2 & 1; c = 2; }
}
DI void attn_qload(const bf16_t* Z, bool samp, int b, int kvh, int c, int wave, int lane, bf16x8 (&qf)[2][2]) {
    const int g = lane >> 4, l15 = lane & 15, head = 4 * kvh + (wave >> 1), t0 = 32 * (wave & 1);
    const int qrow0 = (samp ? MP + 64 * b : b * SEQ + 64 * c) + t0;
#pragma unroll
    for (int qt = 0; qt < 2; ++qt)
#pragma unroll
        for (int ks = 0; ks < 2; ++ks) qf[qt][ks] = *(const bf16x8*)(Z + (size_t)(qrow0 + 16 * qt + l15) * INW + 64 * head + 32 * ks + 8 * g);
}
DI void attn_compute(lds_t* lds, const Params& P, bool samp, int b, int kvh, int c, int wave, int lane, const bf16x8 (&qf)[2][2]) {
    bf16_t* MIX = (bf16_t*)(P.ws + WS_MIX);
    lds_t* Ks = lds; lds_t* Vs = lds + 192 * 144;
    const int g = lane >> 4, l15 = lane & 15;
    const int head = 4 * kvh + (wave >> 1), t0 = 32 * (wave & 1);
    const int qrow0 = (samp ? MP + 64 * b : b * SEQ + 64 * c) + t0;
    const int kt0 = samp ? 0 : (c >= 2 ? 0 : (c == 1 ? 4 : 8));
    const float sink = P.sinks[head] * 1.4426950408889634f;
    f32x4 s[12][2];
#pragma unroll
    for (int kt = 0; kt < 12; ++kt) {
        const bf16x8 k0 = frag_N(Ks, 144, 16 * kt, 0, lane), k1 = frag_N(Ks, 144, 16 * kt, 32, lane);
#pragma unroll
        for (int qt = 0; qt < 2; ++qt) { f32x4 a = {0.f, 0.f, 0.f, 0.f}; a = mfma16(k0, qf[qt][0], a); a = mfma16(k1, qf[qt][1], a); s[kt][qt] = a; }
    }
    float inv[2];
#pragma unroll
    for (int qt = 0; qt < 2; ++qt) {
        float mx = -INFINITY;
#pragma unroll
        for (int kt = 0; kt < 12; ++kt)
#pragma unroll
            for (int i = 0; i < 4; ++i) { s[kt][qt][i] = (kt < kt0) ? -INFINITY : s[kt][qt][i] * 1.4426950408889634f; mx = fmaxf(mx, s[kt][qt][i]); }
        mx = fmaxf(mx, __shfl_xor(mx, 16)); mx = fmaxf(mx, __shfl_xor(mx, 32));
        mx = fmaxf(mx, sink);
        float sum = 0.f;
#pragma unroll
        for (int kt = 0; kt < 12; ++kt)
#pragma unroll
            for (int i = 0; i < 4; ++i) { const float p = __builtin_amdgcn_exp2f(s[kt][qt][i] - mx); s[kt][qt][i] = p; sum += p; }
        sum += __shfl_xor(sum, 16); sum += __shfl_xor(sum, 32);
        sum += __builtin_amdgcn_exp2f(sink - mx);
        inv[qt] = 1.0f / sum;
    }
#pragma unroll
    for (int dt = 0; dt < 4; ++dt) {
        f32x4 o0 = {0.f, 0.f, 0.f, 0.f}, o1 = {0.f, 0.f, 0.f, 0.f};
#pragma unroll
        for (int kk = 0; kk < 6; ++kk) { const bf16x8 vf = frag_Tp(Vs, 144, 32 * kk, 16 * dt, lane); o0 = mfma16(vf, pack8(s[2 * kk][0], s[2 * kk + 1][0]), o0); o1 = mfma16(vf, pack8(s[2 * kk][1], s[2 * kk + 1][1]), o1); }
        o0 = o0 * inv[0]; o1 = o1 * inv[1];
        const int col = 64 * head + 16 * dt + 4 * g;
        u32x2 w0 = {pk(o0[0], o0[1]), pk(o0[2], o0[3])}, w1 = {pk(o1[0], o1[1]), pk(o1[2], o1[3])};
        st8(MIX + (size_t)(qrow0 + l15) * DM + col, w0, samp);
        st8(MIX + (size_t)(qrow0 + 16 + l15) * DM + col, w1, samp);
    }
}
struct AttnRegs { u32x4 k[3], v[3]; bf16x8 q[2][2]; };
DI void attn_load(const bf16_t* Z, int unit, int tid, int wave, int lane, AttnRegs& R) {
    bool samp; int b, kvh, c; attn_decode(unit, samp, b, kvh, c);
#pragma unroll
    for (int i = 0; i < 3; ++i) {
        const int v = tid + 512 * i, key = v >> 3, d0 = (v & 7) * 8, pos = 64 * (c - 2) + key;
        R.k[i] = (u32x4){0u, 0u, 0u, 0u}; R.v[i] = (u32x4){0u, 0u, 0u, 0u};
        if (pos >= 0) { const bf16_t* zr = Z + (size_t)(b * SEQ + pos) * INW; R.k[i] = *(const u32x4*)(zr + 512 + 64 * kvh + d0); R.v[i] = *(const u32x4*)(zr + 640 + 64 * kvh + d0); }
    }
    attn_qload(Z, false, b, kvh, c, wave, lane, R.q);
}
DI void attn_prompt_loop(lds_t* lds, const Params& P, int G, int bx, int tid, int wave, int lane) {
    const bf16_t* Z = (const bf16_t*)(P.ws + WS_Z);
    lds_t* Ks = lds; lds_t* Vs = lds + 192 * 144;
    AttnRegs R;
    int u = bx;
    if (u < 512) attn_load(Z, u, tid, wave, lane, R);
    for (; u < 512; u += G) {
#pragma unroll
        for (int i = 0; i < 3; ++i) { const int v = tid + 512 * i, key = v >> 3, d0 = (v & 7) * 8; *(LAS u32x4*)(Ks + key * 144 + d0 * 2) = R.k[i]; *(LAS u32x4*)(Vs + key * 144 + d0 * 2) = R.v[i]; }
        bf16x8 qf[2][2];
#pragma unroll
        for (int qt = 0; qt < 2; ++qt)
#pragma unroll
            for (int ks = 0; ks < 2; ++ks) qf[qt][ks] = R.q[qt][ks];
        __syncthreads();
        if (u + G < 512) attn_load(Z, u + G, tid, wave, lane, R);
        bool samp; int b, kvh, c; attn_decode(u, samp, b, kvh, c);
        attn_compute(lds, P, false, b, kvh, c, wave, lane, qf);
        __syncthreads();
    }
}
DI void attn_unit(lds_t* lds, const Params& P, int unit, int tid, int wave, int lane) {
    const bf16_t* Z = (const bf16_t*)(P.ws + WS_Z);
    const bool samp = unit >= 512;
    int b, kvh, c;
    if (!samp) { b = unit >> 6; kvh = (unit >> 5) & 1; c = unit & 31; } else { const int u2 = unit - 512; b = u2 >> 1; kvh = u2 & 1; c = 2; }
    lds_t* Ks = lds; lds_t* Vs = lds + 192 * 144;
    for (int v = tid; v < 1536; v += 512) {
        const int key = v >> 3, d0 = (v & 7) * 8;
        u32x4 kv = {0u, 0u, 0u, 0u}, vv = {0u, 0u, 0u, 0u};
        if (samp && key < 128) {
            const size_t off = ((size_t)(b * 128 + key) * 2 + kvh) * 64 + d0;
            const f32x4 a = *(const f32x4*)(P.cache_k + off), a2 = *(const f32x4*)(P.cache_k + off + 4);
            const f32x4 e = *(const f32x4*)(P.cache_v + off), e2 = *(const f32x4*)(P.cache_v + off + 4);
            kv = (u32x4){pk(a[0], a[1]), pk(a[2], a[3]), pk(a2[0], a2[1]), pk(a2[2], a2[3])};
            vv = (u32x4){pk(e[0], e[1]), pk(e[2], e[3]), pk(e2[0], e2[1]), pk(e2[2], e2[3])};
        } else {
            int row = -1;
            if (samp) row = MP + 64 * b + key - 128; else { const int pos = 64 * (c - 2) + key; if (pos >= 0) row = b * SEQ + pos; }
            if (row >= 0) { const bf16_t* zr = Z + (size_t)row * INW; kv = *(const u32x4*)(zr + 512 + 64 * kvh + d0); vv = *(const u32x4*)(zr + 640 + 64 * kvh + d0); }
        }
        *(LAS u32x4*)(Ks + key * 144 + d0 * 2) = kv; *(LAS u32x4*)(Vs + key * 144 + d0 * 2) = vv;
    }
    __syncthreads();
    bf16x8 qf[2][2];
    attn_qload(Z, samp, b, kvh, c, wave, lane, qf);
    attn_compute(lds, P, samp, b, kvh, c, wave, lane, qf);
    __syncthreads();
}

DI void ret_decode(int ru, bool& samp, int& b, int& c, int& h, int& row0) {
    samp = ru >= 1024; h = ru & 3;
    if (!samp) { b = ru >> 7; c = (ru >> 2) & 31; row0 = b * SEQ + 64 * c; } else { b = (ru - 1024) >> 2; c = 0; row0 = MP + 64 * b; }
}
DI float log2_gamma(int h) { return log2f(1.0f - exp2f(-5.0f - (float)h)); }

struct KvRegs { u32x4 k[2], v[2]; };
DI void retkv_load(const bf16_t* Z, int ru, int tid, KvRegs& R) {
    bool samp; int b, c, h, row0; ret_decode(ru, samp, b, c, h, row0);
#pragma unroll
    for (int i = 0; i < 2; ++i) { const int v = tid + 512 * i, j = v >> 4, d0 = (v & 15) * 8; const bf16_t* zr = Z + (size_t)(row0 + j) * INW;
        R.k[i] = *(const u32x4*)(zr + 1280 + 128 * h + d0); R.v[i] = *(const u32x4*)(zr + 1792 + 128 * h + d0); }
}
DI void retkv_stage(lds_t* lds, float l2g, int tid, const KvRegs& R) {
    lds_t* Ks = lds; lds_t* Vs = lds + 64 * 272;
#pragma unroll
    for (int i = 0; i < 2; ++i) { const int v = tid + 512 * i, j = v >> 4, d0 = (v & 15) * 8;
        const float dec = exp2f((float)(63 - j) * l2g); const u32x4 kv = R.k[i];
        u32x4 ks;
        ks.x = pk(bflo(kv.x) * dec, bfhi(kv.x) * dec); ks.y = pk(bflo(kv.y) * dec, bfhi(kv.y) * dec);
        ks.z = pk(bflo(kv.z) * dec, bfhi(kv.z) * dec); ks.w = pk(bflo(kv.w) * dec, bfhi(kv.w) * dec);
        *(LAS u32x4*)(Ks + j * 272 + d0 * 2) = ks; *(LAS u32x4*)(Vs + j * 272 + d0 * 2) = R.v[i]; }
}
DI void retkv_compute(lds_t* lds, const Params& P, bool samp, int b, int c, int h, float l2g, int wave, int lane) {
    lds_t* Ks = lds; lds_t* Vs = lds + 64 * 272;
    f32x4 acc[8];
#pragma unroll
    for (int et = 0; et < 8; ++et) acc[et] = (f32x4){0.f, 0.f, 0.f, 0.f};
#pragma unroll
    for (int ks = 0; ks < 2; ++ks) {
        const bf16x8 a = frag_T(Ks, 272, 32 * ks, 16 * wave, lane);
#pragma unroll
        for (int et = 0; et < 8; ++et) acc[et] = mfma16(a, frag_T(Vs, 272, 32 * ks, 16 * et, lane), acc[et]);
    }
    const int g = lane >> 4, l15 = lane & 15;
    if (!samp) {
        bf16_t* U = (bf16_t*)(P.ws + WS_US) + ((size_t)(b * 32 + c) * 4 + h) * 16384;
#pragma unroll
        for (int et = 0; et < 8; ++et) { u32x2 w = {pk(acc[et][0], acc[et][1]), pk(acc[et][2], acc[et][3])}; *(u32x2*)(U + (16 * et + l15) * 128 + 16 * wave + 4 * g) = w; }
    } else {
        const float g64 = exp2f(64.0f * l2g);
        const float* S0 = P.state + (size_t)(b * 4 + h) * 16384; float* O = P.out + O_NRS + (size_t)(b * 4 + h) * 16384;
#pragma unroll
        for (int et = 0; et < 8; ++et)
#pragma unroll
            for (int i = 0; i < 4; ++i) { const int o = (16 * wave + 4 * g + i) * 128 + 16 * et + l15; O[o] = g64 * S0[o] + acc[et][i]; }
    }
}
DI void retkv_loop(lds_t* lds, const Params& P, int u_lo, int u_hi, int first, int G, int tid, int wave, int lane) {
    const bf16_t* Z = (const bf16_t*)(P.ws + WS_Z);
    KvRegs R; int u = u_lo + first;
    if (u < u_hi) retkv_load(Z, u, tid, R);
    for (; u < u_hi; u += G) {
        bool samp; int b, c, h, row0; ret_decode(u, samp, b, c, h, row0);
        const float l2g = log2_gamma(h);
        retkv_stage(lds, l2g, tid, R);
        __syncthreads();
        if (u + G < u_hi) retkv_load(Z, u + G, tid, R);
        retkv_compute(lds, P, samp, b, c, h, l2g, wave, lane);
        __syncthreads();
    }
}

DI void ret_scan(const Params& P, int G, int bx, int tid) {
    const bf16_t* US = (const bf16_t*)(P.ws + WS_US); bf16_t* SB = (bf16_t*)(P.ws + WS_SB);
    for (int idx = bx * 512 + tid; idx < NB * 4 * 4096; idx += G * 512) {
        const int bh = idx >> 12, e4 = (idx & 4095) * 4, b = bh >> 2, h = bh & 3;
        const float g64 = exp2f(64.0f * log2_gamma(h));
        f32x4 s = {0.f, 0.f, 0.f, 0.f};
#pragma unroll 8
        for (int c = 0; c < 32; ++c) {
            const size_t o = ((size_t)(b * 32 + c) * 4 + h) * 16384 + e4;
            const u32x2 ub = __builtin_nontemporal_load((const u32x2*)(US + o));
            s = s * g64 + (f32x4){bflo(ub.x), bfhi(ub.x), bflo(ub.y), bfhi(ub.y)};
            u32x2 w = {pk(s[0], s[1]), pk(s[2], s[3])};
            *(u32x2*)(SB + o) = w;
        }
        const int e = e4 >> 7, dk = e4 & 127;
        float* o = P.out + O_NRP + (size_t)bh * 16384 + e;
#pragma unroll
        for (int i = 0; i < 4; ++i) o[(dk + i) * 128] = s[i];
    }
}

struct OutRegs { u32x4 q[2], k[2], v[2], s[4]; u32x2 gt[4]; };
DI void retout_load(const Params& P, int ru, int tid, int wave, int lane, OutRegs& R) {
    const bf16_t* Z = (const bf16_t*)(P.ws + WS_Z);
    bool samp; int b, c, h, row0; ret_decode(ru, samp, b, c, h, row0);
#pragma unroll
    for (int i = 0; i < 2; ++i) { const int v = tid + 512 * i, j = v >> 4, d0 = (v & 15) * 8; const bf16_t* zr = Z + (size_t)(row0 + j) * INW;
        R.q[i] = __builtin_nontemporal_load((const u32x4*)(zr + 768 + 128 * h + d0)); R.k[i] = __builtin_nontemporal_load((const u32x4*)(zr + 1280 + 128 * h + d0)); R.v[i] = __builtin_nontemporal_load((const u32x4*)(zr + 1792 + 128 * h + d0)); }
    const bf16_t* S = (const bf16_t*)(P.ws + WS_SB) + ((size_t)(b * 32 + (c > 0 ? c - 1 : 0)) * 4 + h) * 16384;
#pragma unroll
    for (int i = 0; i < 4; ++i) { const int v = tid + 512 * i, dk = v >> 4, e0 = (v & 15) * 8; R.s[i] = (u32x4){0u, 0u, 0u, 0u}; if (c > 0) R.s[i] = __builtin_nontemporal_load((const u32x4*)(S + dk * 128 + e0)); }
    const int g = lane >> 4, i_ = 16 * (wave & 3) + (lane & 15), eh = wave >> 2;
#pragma unroll
    for (int et = 0; et < 4; ++et) R.gt[et] = *(const u32x2*)(Z + (size_t)(row0 + i_) * INW + 2304 + 128 * h + 64 * eh + 16 * et + 4 * g);
}
DI void retout_stage(lds_t* lds, int tid, const OutRegs& R) {
    lds_t* Qs = lds; lds_t* Ks = lds + 17408; lds_t* Vs = lds + 2 * 17408; lds_t* Ss = lds + 3 * 17408;
#pragma unroll
    for (int i = 0; i < 2; ++i) { const int v = tid + 512 * i, j = v >> 4, d0 = (v & 15) * 8;
        *(LAS u32x4*)(Qs + j * 272 + d0 * 2) = R.q[i]; *(LAS u32x4*)(Ks + j * 272 + d0 * 2) = R.k[i]; *(LAS u32x4*)(Vs + j * 272 + d0 * 2) = R.v[i]; }
#pragma unroll
    for (int i = 0; i < 4; ++i) { const int v = tid + 512 * i, dk = v >> 4, e0 = (v & 15) * 8; *(LAS u32x4*)(Ss + dk * 272 + e0 * 2) = R.s[i]; }
}
DI void retout_compute(lds_t* lds, const Params& P, int row0, int h, float l2g, bool has_state, int wave, int lane, const u32x2 (&gt)[4], bool wt) {
    bf16_t* MIX = (bf16_t*)(P.ws + WS_MIX);
    lds_t* Qs = lds; lds_t* Ks = lds + 17408; lds_t* Vs = lds + 2 * 17408; lds_t* Ss = lds + 3 * 17408; LAS float* ssx = (LAS float*)(lds + 3 * 17408 + 128 * 272);
    const int g = lane >> 4, l15 = lane & 15, it = wave & 3, eh = wave >> 2;
    const int i_ = 16 * it + l15;
    bf16x8 qf[4];
#pragma unroll
    for (int ks = 0; ks < 4; ++ks) qf[ks] = frag_N(Qs, 272, 16 * it, 32 * ks, lane);
    f32x4 p[4];
#pragma unroll
    for (int jt = 0; jt < 4; ++jt) {
        f32x4 a = {0.f, 0.f, 0.f, 0.f};
        if (jt <= it) {
#pragma unroll
            for (int ks = 0; ks < 4; ++ks) a = mfma16(frag_N(Ks, 272, 16 * jt, 32 * ks, lane), qf[ks], a);
#pragma unroll
            for (int i = 0; i < 4; ++i) { const int j_ = 16 * jt + 4 * g + i; a[i] = (i_ >= j_) ? a[i] * exp2f((float)(i_ - j_) * l2g) : 0.f; }
        }
        p[jt] = a;
    }
    const bf16x8 pf0 = pack8(p[0], p[1]), pf1 = pack8(p[2], p[3]);
    f32x4 acc[4];
    const float qdec = exp2f((float)(i_ + 1) * l2g);
    float ss = 0.f;
#pragma unroll
    for (int et = 0; et < 4; ++et) {
        const int e0 = 64 * eh + 16 * et;
        f32x4 a = {0.f, 0.f, 0.f, 0.f};
        if (has_state) {
#pragma unroll
            for (int ks = 0; ks < 4; ++ks) a = mfma16(frag_N(Ss, 272, e0, 32 * ks, lane), qf[ks], a);
            a = a * qdec;
        }
        a = mfma16(frag_Tp(Vs, 272, 0, e0, lane), pf0, a);
        a = mfma16(frag_Tp(Vs, 272, 32, e0, lane), pf1, a);
        acc[et] = a;
        ss += (a[0] * a[0] + a[1] * a[1]) + (a[2] * a[2] + a[3] * a[3]);
    }
    ss += __shfl_xor(ss, 16); ss += __shfl_xor(ss, 32);
    if (g == 0) ssx[eh * 64 + i_] = ss;
    __syncthreads();
    const float rn = rsqrtf((ssx[i_] + ssx[64 + i_]) * (1.0f / 128.0f) + EPS);
    const size_t row = (size_t)(row0 + i_);
#pragma unroll
    for (int et = 0; et < 4; ++et) {
        const int e = 64 * eh + 16 * et + 4 * g;
        const float g0 = bflo(gt[et].x), g1 = bfhi(gt[et].x), g2 = bflo(gt[et].y), g3 = bfhi(gt[et].y);
        const float o0 = acc[et][0] * rn * (g0 / (1.0f + __expf(-g0))), o1 = acc[et][1] * rn * (g1 / (1.0f + __expf(-g1)));
        const float o2 = acc[et][2] * rn * (g2 / (1.0f + __expf(-g2))), o3 = acc[et][3] * rn * (g3 / (1.0f + __expf(-g3)));
        u32x2 w = {pk(o0, o1), pk(o2, o3)};
        st8(MIX + row * DM + 512 + 128 * h + e, w, wt);
    }
}
DI void retout_prompt_loop(lds_t* lds, const Params& P, int G, int bx, int tid, int wave, int lane) {
    OutRegs R; int u = bx;
    if (u < 1024) retout_load(P, u, tid, wave, lane, R);
    for (; u < 1024; u += G) {
        bool samp; int b, c, h, row0; ret_decode(u, samp, b, c, h, row0);
        retout_stage(lds, tid, R);
        u32x2 gt[4];
#pragma unroll
        for (int et = 0; et < 4; ++et) gt[et] = R.gt[et];
        __syncthreads();
        if (u + G < 1024) retout_load(P, u + G, tid, wave, lane, R);
        retout_compute(lds, P, row0, h, log2_gamma(h), true, wave, lane, gt, false);
        __syncthreads();
    }
}
DI void retout_sample_unit(lds_t* lds, const Params& P, int ru, int tid, int wave, int lane) {
    const bf16_t* Z = (const bf16_t*)(P.ws + WS_Z);
    bool samp; int b, c, h, row0; ret_decode(ru, samp, b, c, h, row0);
    lds_t* Qs = lds; lds_t* Ks = lds + 17408; lds_t* Vs = lds + 2 * 17408; lds_t* Ss = lds + 3 * 17408;
    for (int v = tid; v < 1024; v += 512) {
        const int j = v >> 4, d0 = (v & 15) * 8;
        const bf16_t* zr = Z + (size_t)(row0 + j) * INW;
        *(LAS u32x4*)(Qs + j * 272 + d0 * 2) = *(const u32x4*)(zr + 768 + 128 * h + d0);
        *(LAS u32x4*)(Ks + j * 272 + d0 * 2) = *(const u32x4*)(zr + 1280 + 128 * h + d0);
        *(LAS u32x4*)(Vs + j * 272 + d0 * 2) = *(const u32x4*)(zr + 1792 + 128 * h + d0);
    }
    const float* S = P.state + (size_t)(b * 4 + h) * 16384;
    for (int v = tid; v < 2048; v += 512) { const int dk = v >> 4, e0 = (v & 15) * 8; const f32x4 a = *(const f32x4*)(S + dk * 128 + e0), a2 = *(const f32x4*)(S + dk * 128 + e0 + 4);
        const unsigned p0 = pk(a[0], a[1]), p1 = pk(a[2], a[3]), p2 = pk(a2[0], a2[1]), p3 = pk(a2[2], a2[3]);
        LAS unsigned short* d = (LAS unsigned short*)(Ss + e0 * 272 + dk * 2);
        d[0 * 136] = (unsigned short)p0; d[1 * 136] = (unsigned short)(p0 >> 16); d[2 * 136] = (unsigned short)p1; d[3 * 136] = (unsigned short)(p1 >> 16);
        d[4 * 136] = (unsigned short)p2; d[5 * 136] = (unsigned short)(p2 >> 16); d[6 * 136] = (unsigned short)p3; d[7 * 136] = (unsigned short)(p3 >> 16); }
    u32x2 gt[4];
    { const int g = lane >> 4, i_ = 16 * (wave & 3) + (lane & 15), eh = wave >> 2;
#pragma unroll
      for (int et = 0; et < 4; ++et) gt[et] = *(const u32x2*)(Z + (size_t)(row0 + i_) * INW + 2304 + 128 * h + 64 * eh + 16 * et + 4 * g); }
    __syncthreads();
    retout_compute(lds, P, row0, h, log2_gamma(h), true, wave, lane, gt, true);
    __syncthreads();
}

DI void final_norm(const Params& P, int G, int wave, int lane, float* dst) {
    const int gw = blockIdx.x * 8 + wave, NGW = G * 8;
    const bf16_t* h1b = (const bf16_t*)(P.ws + WS_H1B);
    for (int m = MP + gw; m < MT; m += NGW) {
        f32x4 v[4]; float s = 0.f;
#pragma unroll
        for (int j = 0; j < 4; ++j) { const u32x2 hb = *(const u32x2*)(h1b + (size_t)m * DM + 4 * lane + 256 * j); v[j] = (f32x4){bflo(hb.x), bfhi(hb.x), bflo(hb.y), bfhi(hb.y)}; }
        const bf16_t* sl = (const bf16_t*)(P.ws + WS_SLAB) + (size_t)(m - MP) * DM + 4 * lane;
#pragma unroll
        for (int q = 0; q < NSPLIT_DN; ++q)
#pragma unroll
            for (int j = 0; j < 4; ++j) { const u32x2 sb = *(const u32x2*)(sl + (size_t)q * ((size_t)MS * DM) + 256 * j); v[j] += (f32x4){bflo(sb.x), bfhi(sb.x), bflo(sb.y), bfhi(sb.y)}; }
#pragma unroll
        for (int j = 0; j < 4; ++j) s += (v[j][0] * v[j][0] + v[j][1] * v[j][1]) + (v[j][2] * v[j][2] + v[j][3] * v[j][3]);
        const float rs = rsqrtf(wave_sum(s) * (1.0f / DM) + EPS);
#pragma unroll
        for (int j = 0; j < 4; ++j) *(f32x4*)(dst + (size_t)m * DM + 4 * lane + 256 * j) = v[j] * rs * *(const f32x4*)(P.norm_f + 4 * lane + 256 * j);
    }
}

#ifndef USE_COOP
#define USE_COOP 1
#endif
__global__ void __launch_bounds__(512, 2) fwd_megakernel(Params P) {
    extern __shared__ __attribute__((aligned(16))) unsigned char lds_raw[];
    lds_t* lds = (lds_t*)lds_raw;
#define FRESH_IDS const int tid = tid_of(wave0), lane = tid & 63, wave = wave0; (void)lane; (void)wave
    const int G = gridDim.x, bx = (int)blockIdx.x;
    unsigned char* ws = P.ws;
    volatile LAS unsigned* misc = (volatile LAS unsigned*)(lds + 131072 + 512);
    const int wave0 = __builtin_amdgcn_readfirstlane((int)threadIdx.x >> 6);
    if (threadIdx.x < 2) misc[threadIdx.x] = 0u;
    __syncthreads();
    XcdBarrier bar = xcd_barrier_post((unsigned*)(ws + WS_BAR), misc); bar.w0 = wave0;
    const bool subset = G >= 128;
    const int NS2 = subset ? 16 : 0, NS4 = subset ? 64 : 0;

    { FRESH_IDS; p0_prologue(P, lds, G, tid, wave, lane, true); }
    xcd_barrier(bar);
    {
        pg8::Gemm g{(const bf16_t*)(ws + WS_XN), (const bf16_t*)(ws + WS_WIN), MT, INW, DM}; pg8::StaticOrder S; S.init(MT, INW, DM, G, bx);
        pg8::EpiInProj E{(bf16_t*)(ws + WS_Z), (const float*)(ws + WS_RS1), P.out};
        pg8::gemm_phase<pg8::EpiInProj, pg8::StaticOrder, true, true>(lds, g, S, E, wave0);
    }
    xcd_barrier(bar);
    {
      const int GP = G - NS2;
      unsigned* flag = (unsigned*)(ws + WS_FLAG);
      if (bx < GP) {
        { FRESH_IDS; int u = bx - 32 % GP; if (u < 0) u += GP; for (; u < 32; u += GP) attn_unit(lds, P, 512 + u, tid, wave, lane); }
        { FRESH_IDS; int u = bx - 64 % GP; if (u < 0) u += GP; for (; u < 64; u += GP) retout_sample_unit(lds, P, 1024 + u, tid, wave, lane); }
        if (NS2 > 0) {
            asm volatile("s_waitcnt vmcnt(0)" ::: "memory"); __syncthreads();
            if (wave0 == 0 && lane_id() == 0) __hip_atomic_fetch_add(flag, 1u, __ATOMIC_RELAXED, __HIP_MEMORY_SCOPE_AGENT);
        }
        { FRESH_IDS; int f = bx - 128 % GP; if (f < 0) f += GP; retkv_loop(lds, P, 1024, 1088, f, GP, tid, wave, lane); }
        { FRESH_IDS;
          const int vb = (GP % 8 == 0) ? (bx % 8) * (GP / 8) + bx / 8 : bx;
          attn_prompt_loop(lds, P, GP, vb, tid, wave, lane);
          retkv_loop(lds, P, 0, 1024, GP - 1 - vb, GP, tid, wave, lane);
        }
        { FRESH_IDS; p2_ffn_weights(P, lds, GP, bx, wave, lane); }
      } else {
        if (wave0 == 0) {
            unsigned sp = 0;
            while ((unsigned)__builtin_amdgcn_readfirstlane(__hip_atomic_load(flag, __ATOMIC_RELAXED, __HIP_MEMORY_SCOPE_AGENT)) < (unsigned)GP) { __builtin_amdgcn_s_sleep(8); if (++sp > (1u << 22)) break; }
            __builtin_amdgcn_fence(__ATOMIC_ACQUIRE, "agent");
            asm volatile("s_waitcnt vmcnt(0)" ::: "memory");
        }
        __syncthreads();
        pg8::Gemm g{(const bf16_t*)(ws + WS_MIX), (const bf16_t*)(ws + WS_WOUT), MT, DM, DM}; pg8::SubsetOrder S; S.init(MP / 256, DM / 256, DM, NS2, bx - GP);
        pg8::EpiOutProjDma E{(const bf16_t*)(ws + WS_XN), (bf16_t*)(ws + WS_H1B), (float*)(ws + WS_ROWSS2)};
        pg8::gemm_phase<pg8::EpiOutProjDma, pg8::SubsetOrder, true, true>(lds, g, S, E, wave0);
      }
    }
    xcd_barrier(bar);
    { FRESH_IDS; ret_scan(P, G, bx, tid); }
    xcd_barrier(bar);
    if (bx < NS4) {
        pg8::Gemm g{(const bf16_t*)(ws + WS_H1B), (const bf16_t*)(ws + WS_WUP), MT, FF, DM}; pg8::SubsetOrder S; S.init(MP / 256, FF / 256, DM, NS4, bx);
        pg8::EpiUp E{(const float*)(ws + WS_ROWSS2), (bf16_t*)(ws + WS_U)};
        pg8::gemm_phase<pg8::EpiUp, pg8::SubsetOrder, true, true>(lds, g, S, E, wave0);
    } else { FRESH_IDS; retout_prompt_loop(lds, P, G - NS4, bx - NS4, tid, wave, lane); }
    xcd_barrier(bar);
    {
        const int M5 = subset ? MP : MT;
        pg8::Gemm g{(const bf16_t*)(ws + WS_MIX), (const bf16_t*)(ws + WS_WOUT), M5, DM, DM}; pg8::StaticOrder S; S.init(M5, DM, DM, G, bx);
        if (G >= 256) {
            pg8::EpiOutProjDma E{(const bf16_t*)(ws + WS_XN), (bf16_t*)(ws + WS_H1B), (float*)(ws + WS_ROWSS2)};
            pg8::gemm_phase<pg8::EpiOutProjDma, pg8::StaticOrder, true, true>(lds, g, S, E, wave0);
        } else {
            pg8::EpiOutProj E{(const bf16_t*)(ws + WS_XN), (bf16_t*)(ws + WS_H1B), (float*)(ws + WS_ROWSS2)};
            pg8::gemm_phase<pg8::EpiOutProj, pg8::StaticOrder, true, true>(lds, g, S, E, wave0);
        }
    }
    xcd_barrier(bar);
    {
        const int M6 = subset ? MP : MT;
        pg8::Gemm g{(const bf16_t*)(ws + WS_H1B), (const bf16_t*)(ws + WS_WUP), M6, FF, DM}; pg8::StaticOrder S; S.init(M6, FF, DM, G, bx);
        pg8::EpiUp E{(const float*)(ws + WS_ROWSS2), (bf16_t*)(ws + WS_U)};
        pg8::gemm_phase<pg8::EpiUp, pg8::StaticOrder, true, true>(lds, g, S, E, wave0);
    }
    xcd_barrier(bar);
    {
        pg8::Gemm g{(const bf16_t*)(ws + WS_U), (const bf16_t*)(ws + WS_WDN), MT, DM, FF}; pg8::TailSplitOrder S; S.init(MP, DM, FF, G, bx, MS / 256, NSPLIT_DN);
        pg8::EpiDownNorm E{(const bf16_t*)(ws + WS_H1B), P.out + O_Y, (bf16_t*)(ws + WS_SLAB), P.norm_f, (float*)(ws + WS_XBUF), (unsigned*)(ws + WS_CNT)};
        pg8::gemm_phase<pg8::EpiDownNorm, pg8::TailSplitOrder, true, true>(lds, g, S, E, wave0);
    }
    xcd_barrier(bar);
    { FRESH_IDS; final_norm(P, G, wave, lane, P.out + O_Y); }
}


extern "C" void kernel_launch(void* const* d_in, const int* in_sizes, int n_in, void* d_out, int out_size, void* d_ws, size_t ws_size, hipStream_t stream) {
    static int grid = 0;
    if (grid == 0) {
        int dev = 0, cus = 0, per_cu = 0;
        hipGetDevice(&dev);
        hipDeviceGetAttribute(&cus, hipDeviceAttributeMultiprocessorCount, dev);
        if (hipFuncSetAttribute((const void*)fwd_megakernel, hipFuncAttributeMaxDynamicSharedMemorySize, LDS_BYTES) != hipSuccess) { fprintf(stderr, "hipFuncSetAttribute failed\n"); }
        if (hipOccupancyMaxActiveBlocksPerMultiprocessor(&per_cu, (const void*)fwd_megakernel, 512, LDS_BYTES) != hipSuccess || per_cu < 1) { fprintf(stderr, "occupancy query: %d\n", per_cu); per_cu = 1; }
        (void)hipGetLastError();
        grid = cus * per_cu;
        fprintf(stderr, "kernel_launch: cus %d per_cu %d grid %d ws %zu\n", cus, per_cu, grid, ws_size);
    }
    hipMemsetAsync((char*)d_ws + WS_CTL, 0, CTL_BYTES, stream);
    Params p{};
    p.xp = (const float*)d_in[0]; p.xs = (const float*)d_in[1]; p.cache_k = (const float*)d_in[2]; p.cache_v = (const float*)d_in[3]; p.state = (const float*)d_in[4];
    p.norm1 = (const float*)d_in[5]; p.w_in = (const float*)d_in[6]; p.sinks = (const float*)d_in[7]; p.w_out = (const float*)d_in[8]; p.norm2 = (const float*)d_in[9];
    p.w_up = (const float*)d_in[10]; p.w_down = (const float*)d_in[11]; p.norm_f = (const float*)d_in[12];
    p.out = (float*)d_out; p.ws = (unsigned char*)d_ws;
#if USE_COOP
    void* args[] = {&p};
    hipError_t e = hipLaunchCooperativeKernel((const void*)fwd_megakernel, dim3(grid), dim3(512), args, LDS_BYTES, stream);
    if (e != hipSuccess) fprintf(stderr, "cooperative launch failed: %s (grid %d)\n", hipGetErrorString(e), grid);
#else
    hipLaunchKernelGGL(fwd_megakernel, dim3(grid), dim3(512), LDS_BYTES, stream, p);
#endif
}
```

```cpp
#include <hip/hip_runtime.h>
#include <cstdio>
#include <cstdint>

#define DI __device__ __forceinline__
#define LAS __attribute__((address_space(3)))
typedef unsigned short bf16_t;
typedef short bf16x8 __attribute__((ext_vector_type(8)));
typedef short s16x4 __attribute__((ext_vector_type(4)));
typedef float f32x4 __attribute__((ext_vector_type(4)));
typedef float f32x2 __attribute__((ext_vector_type(2)));
typedef unsigned u32x4 __attribute__((ext_vector_type(4)));
typedef unsigned u32x2 __attribute__((ext_vector_type(2)));
typedef __bf16 bf16x2_t __attribute__((ext_vector_type(2)));
typedef LAS unsigned char lds_t;

DI int lane_id() { return (int)__builtin_amdgcn_mbcnt_hi(~0u, __builtin_amdgcn_mbcnt_lo(~0u, 0u)); }
DI int tid_of(int wave0) { int t = wave0 * 64 + lane_id(); asm volatile("" : "+v"(t)); return t; }
DI unsigned pk(float a, float b) { f32x2 v = {a, b}; bf16x2_t r = __builtin_convertvector(v, bf16x2_t); return __builtin_bit_cast(unsigned, r); }
DI float bflo(unsigned u) { return __uint_as_float(u << 16); }
DI float bfhi(unsigned u) { return __uint_as_float(u & 0xffff0000u); }

constexpr int DM = 1024, NB = 8, SEQ = 2048, DB = 16, DSEQ = 64, PAST = 2048;
constexpr int MP = NB * SEQ;
constexpr int MS = DB * DSEQ;
constexpr int MT = MP + MS;
constexpr int INW = 2816, FF = 4096;
constexpr int NPOS = PAST + DSEQ;
constexpr float EPS = 1e-6f;
constexpr size_t O_Y = 0, O_NKP = 17825792, O_NVP = 17956864, O_NRP = 18087936, O_NKS = 18612224, O_NVS = 18874368, O_NRS = 19136512;
constexpr size_t MiB = 1u << 20;
constexpr size_t WS_CTL = 0, CTL_BYTES = 1 * MiB, WS_ROWSS2 = 1 * MiB + 131072, WS_BAR = 524288, WS_CNT = 262144;
constexpr size_t WS_FLAG = 327680;
constexpr size_t WS_XBUF = 1 * MiB + 524288;
constexpr size_t WS_RS1 = 1 * MiB;
constexpr size_t WS_WIN = 2 * MiB, WS_WOUT = 8 * MiB, WS_WUP = 10 * MiB, WS_WDN = 18 * MiB;
constexpr size_t WS_XN = 26 * MiB;
constexpr size_t WS_MIX = 186 * MiB;
constexpr size_t WS_Z = 60 * MiB;
constexpr size_t WS_US = 154 * MiB;
constexpr size_t WS_SB = 218 * MiB;
constexpr size_t WS_U = 50 * MiB;
constexpr size_t WS_H1B = 220 * MiB;
constexpr size_t WS_SLAB = 186 * MiB;
constexpr int NSPLIT_DN = 8;
constexpr int LDS_BYTES = 147456;
#ifndef WT_STORES
#define WT_STORES 0
#endif

struct Params {
    const float *xp, *xs, *cache_k, *cache_v, *state, *norm1, *w_in, *sinks, *w_out, *norm2, *w_up, *w_down, *norm_f;
    float* out; unsigned char* ws;
};

DI bf16x8 frag_N(const lds_t* base, int rs, int idx0, int k0, int lane) {
    return *(const LAS bf16x8*)(base + (idx0 + (lane & 15)) * rs + (k0 + 8 * (lane >> 4)) * 2);
}
DI s16x4 tr4(const lds_t* a) { return __builtin_amdgcn_ds_read_tr16_b64_v4i16((LAS s16x4*)a); }
DI bf16x8 frag_T(const lds_t* base, int rs, int k0, int idx0, int lane) {
    const int g = lane >> 4, q = (lane >> 2) & 3, p = lane & 3;
    const lds_t* a = base + (k0 + 8 * g + q) * rs + (idx0 + 4 * p) * 2;
    const s16x4 lo = tr4(a), hi = tr4(a + 4 * rs);
    return __builtin_shufflevector(lo, hi, 0, 1, 2, 3, 4, 5, 6, 7);
}
DI bf16x8 frag_Tp(const lds_t* base, int rs, int k0, int idx0, int lane) {
    const int g = lane >> 4, q = (lane >> 2) & 3, p = lane & 3;
    const lds_t* a = base + (k0 + 4 * g + q) * rs + (idx0 + 4 * p) * 2;
    const s16x4 lo = tr4(a), hi = tr4(a + 16 * rs);
    return __builtin_shufflevector(lo, hi, 0, 1, 2, 3, 4, 5, 6, 7);
}
DI f32x4 mfma16(bf16x8 a, bf16x8 b, f32x4 c) { return __builtin_amdgcn_mfma_f32_16x16x32_bf16(a, b, c, 0, 0, 0); }
DI bf16x8 pack8(const f32x4& a, const f32x4& b) { u32x4 w = {pk(a[0], a[1]), pk(a[2], a[3]), pk(b[0], b[1]), pk(b[2], b[3])}; return __builtin_bit_cast(bf16x8, w); }
DI int row_pos(int r) { return r < MP ? (r & (SEQ - 1)) : (PAST + ((r - MP) & (DSEQ - 1))); }

#define XB_TMO      128
#define XB_XCNT(j)  (256  + 64 * (j))
#define XB_XSUB(j)  (1280 + 64 * (j))
#define XB_XGEN(j)  (2304 + 64 * (j))
#define XB_TOP      3328
#define XB_TOPGEN   3392
#define XCD_BAR_WORDS 3456
#define XB_SPIN_CAP (1u << 18)

__device__ __forceinline__ unsigned xb_ld(unsigned* p)              { return __hip_atomic_load(p, __ATOMIC_RELAXED, __HIP_MEMORY_SCOPE_AGENT); }
__device__ __forceinline__ unsigned xb_add(unsigned* p, unsigned v) { return __hip_atomic_fetch_add(p, v, __ATOMIC_RELAXED, __HIP_MEMORY_SCOPE_AGENT); }
__device__ __forceinline__ unsigned xb_xcc_id() { return (unsigned)__builtin_amdgcn_s_getreg((3 << 11) | 20) & 0xFu; }
#define XB_SPIN(cond, bar) do { unsigned _sp = 0; while (cond) { __builtin_amdgcn_s_sleep(1); \
    if ((++_sp & 255u) == 0u) { if (xb_ld(&(bar)[XB_TMO])) break; if (_sp > XB_SPIN_CAP) { atomicAdd(&(bar)[XB_TMO], 1u); break; } } } } while (0)

struct XcdBarrier {
    unsigned* bar; unsigned x; int w0;
    volatile LAS unsigned* st;
};

__device__ __forceinline__ XcdBarrier xcd_barrier_post(unsigned* bar, volatile LAS unsigned* st) {
    XcdBarrier b; b.bar = bar; b.x = xb_xcc_id(); b.st = st;
    if (threadIdx.x == 0) (void)xb_add(&bar[XB_XCNT(b.x)], 1u);
    return b;
}
__device__ __forceinline__ void xcd_barrier_complete(unsigned* bar, unsigned x, unsigned& nloc, unsigned& nx) {
    const unsigned G = gridDim.x * gridDim.y * gridDim.z;
    unsigned sum, cnt, mine, sp = 0u;
    for (;;) {
        sum = 0u; cnt = 0u; mine = 0u;
#pragma unroll
        for (unsigned j = 0; j < 16; ++j) { const unsigned c = xb_ld(&bar[XB_XCNT(j)]); sum += c; cnt += (c > 0u) ? 1u : 0u; mine = (j == x) ? c : mine; }
        if (sum == G) break;
        __builtin_amdgcn_s_sleep(1);
        if ((++sp & 255u) == 0u) { if (xb_ld(&bar[XB_TMO])) break; if (sp > XB_SPIN_CAP) { atomicAdd(&bar[XB_TMO], 1u); break; } }
    }
    nloc = mine > 0u ? mine : 1u; nx = cnt > 0u ? cnt : 1u;
}

__device__ __forceinline__ void xcd_barrier(const XcdBarrier& b) {
    asm volatile("s_waitcnt vmcnt(0)" ::: "memory");
    __syncthreads();
    if (b.w0 == 0 && lane_id() == 0) {
        unsigned* bar = b.bar;
        __builtin_amdgcn_s_waitcnt(0);
        unsigned nloc = b.st[0], nx = b.st[1];
        if (nloc == 0u) { xcd_barrier_complete(bar, b.x, nloc, nx); b.st[0] = nloc; b.st[1] = nx; }
        const unsigned old = xb_add(&bar[XB_XSUB(b.x)], 1u);
        const unsigned gen = old / nloc;
        if (old + 1u == (gen + 1u) * nloc) {
            __builtin_amdgcn_fence(__ATOMIC_RELEASE, "agent");
            asm volatile("s_waitcnt vmcnt(0)" ::: "memory");
            const unsigned og = xb_add(&bar[XB_TOP], 1u);
            const unsigned tg = og / nx;
            if (og + 1u == (tg + 1u) * nx) xb_add(&bar[XB_TOPGEN], 1u);
            else XB_SPIN(xb_ld(&bar[XB_TOPGEN]) == tg, bar);
            __builtin_amdgcn_fence(__ATOMIC_ACQUIRE, "agent");
            xb_add(&bar[XB_XGEN(b.x)], 1u);
            asm volatile("s_waitcnt vmcnt(0)" ::: "memory");
        } else {
            XB_SPIN(xb_ld(&bar[XB_XGEN(b.x)]) == gen, bar);
            __builtin_amdgcn_fence(__ATOMIC_ACQUIRE, "agent");
            asm volatile("s_waitcnt vmcnt(0)" ::: "memory");
        }
    }
    __syncthreads();
}
namespace pg8 {
#define PG8_LAS __attribute__((address_space(3)))
typedef unsigned short bf16_t;
typedef short bf16x8 __attribute__((ext_vector_type(8)));
typedef float f32x4 __attribute__((ext_vector_type(4)));
typedef unsigned u32x4 __attribute__((ext_vector_type(4)));
constexpr int BM = 256, BK = 64, HALF = 128, HTB = HALF * BK * 2  , STAGE_BYTES = 8 * HTB, NXCD = 8, WGM = 8;

__host__ __device__ __forceinline__ int lds_byte(int r, int c) { const int st = (r >> 4) * 2 + (c >> 5), rr = r & 15, cc = c & 31, ob = rr * 64 + cc * 2; return st * 1024 + (ob ^ (((ob >> 9) & 1) << 5)); }
__host__ __device__ __forceinline__ void stage_rc(int b, int& R, int& C) { const int st = b / 1024, sb = b % 1024, swz = sb ^ (((sb >> 9) & 1) << 5); R = (st >> 1) * 16 + swz / 64; C = (st & 1) * 32 + (swz % 64) / 2; }
__host__ __device__ __forceinline__ int perm32(int rho) { const int n = rho >> 4, i = rho & 15; return 8 * (i >> 2) + 4 * n + (i & 3); }

struct Unit { int pm, pn, k0, nt; };
struct Gemm { const bf16_t* A; const bf16_t* Bt; int M, N, K; };

struct StaticOrder {
    int nM, nN, nwg, G, c, ntk;
    __host__ __device__ void init(int M, int N, int K, int G_, int c_) { nM = M / BM; nN = N / BM; nwg = nM * nN; G = G_; c = c_; ntk = K / BK; }
    __host__ __device__ bool next(int i, Unit& u) const { return at((long)i * G + c, u); }
    __host__ __device__ bool at(long L, Unit& u) const {
        if (L >= nwg) return false;
        int wgid = (int)L; { const int q = nwg / NXCD, r = nwg % NXCD, xcd = wgid % NXCD, off = wgid / NXCD; wgid = (xcd < r ? xcd * (q + 1) : r * (q + 1) + (xcd - r) * q) + off; }
        const int nig = WGM * nN, gid = wgid / nig, fm = gid * WGM, gsz = (nM - fm) < WGM ? (nM - fm) : WGM;
        u.pm = fm + ((wgid % nig) % gsz); u.pn = (wgid % nig) / gsz; u.k0 = 0; u.nt = ntk; return true;
    }
    __device__ __forceinline__ void a_ready(const Unit&) const {}
    __device__ __forceinline__ void done(const Unit&) const {}
};


struct TailSplitOrder {
    StaticOrder so; int tailM, nsplit, npieces;
    __host__ __device__ void init(int M, int N, int K, int G_, int c_, int tailM_, int nsplit_) { so.init(M, N, K, G_, c_); tailM = tailM_; nsplit = nsplit_; npieces = tailM_ * so.nN * nsplit_; }
    __host__ __device__ bool next(int i, Unit& u) const {
        const long L = (long)i * so.G + so.c;
        if (L >= npieces) return so.at(L - npieces, u);
        const int p = (int)L, tu = p / nsplit, ks = p % nsplit, nts = so.ntk / nsplit;
        u.pm = so.nM + tu / so.nN; u.pn = tu % so.nN; u.k0 = ks * nts; u.nt = nts; return true;
    }
    __device__ __forceinline__ void a_ready(const Unit&) const {}
    __device__ __forceinline__ void done(const Unit&) const {}
};

struct SubsetOrder {
    int pm0, nN, ntk, cnt, c;
    __host__ __device__ void init(int pm0_, int nN_, int K, int cnt_, int c_) { pm0 = pm0_; nN = nN_; ntk = K / BK; cnt = cnt_; c = c_; }
    __host__ __device__ bool next(int i, Unit& u) const { if (i != 0 || c >= cnt) return false; u.pm = pm0 + c / nN; u.pn = c % nN; u.k0 = 0; u.nt = ntk; return true; }
    __device__ __forceinline__ void a_ready(const Unit&) const {}
    __device__ __forceinline__ void done(const Unit&) const {}
};

DI void st8bf(bf16_t* p, const f32x4& a, const f32x4& b) { u32x4 w = {pk(a[0], a[1]), pk(a[2], a[3]), pk(b[0], b[1]), pk(b[2], b[3])};
#if WT_STORES
    asm volatile("global_store_dwordx4 %0, %1, off sc1\n\ts_nop 1" :: "v"(p), "v"(w) : "memory");
#else
    *(u32x4*)p = w;
#endif
}
struct EpiInProj {
    static constexpr bool PERM = true, AFTER_DRAIN = false, LAST_FUSED = false;
    bf16_t* Z; const float* rowscale; float* out;
    __device__ __forceinline__ void operator()(const f32x4 (&acc)[2][2][4][2], const Unit& u, int wr, int wc, int fr, int fq) const {
        const int pn = u.pn;
        const int kind = pn >= 7 ? 0 : (pn >= 3 ? 1 : ((pn < 2 || wc < 2) ? 2 : 3));
        const int i0 = kind == 1 ? 32 * (wc & 1) + 8 * fq : 8 * fq;
        const int rbase = u.pm * BM + wr * 64 + fr;
        const bool rope = kind == 1 || kind == 2;
        float revf[8];
#pragma unroll
        for (int e = 0; e < 8; ++e) { const float x = kind == 1 ? (float)(i0 + e) * (1.0f / 63.0f) : (float)(i0 + e) * (1.0f / 32.0f); revf[e] = exp2f(-x * 13.287712379549449f) * 0.15915494309189535f; }
        float rsv[8];
#pragma unroll
        for (int idx = 0; idx < 8; ++idx) rsv[idx] = rowscale[rbase + (idx >> 2) * HALF + (idx & 3) * 16];
        f32x4 cd0, sd0, cd1, sd1;
        if (rope) {
#pragma unroll
            for (int e = 0; e < 4; ++e) {
                const float f0 = __builtin_amdgcn_fractf(16.0f * revf[e]), f1 = __builtin_amdgcn_fractf(16.0f * revf[4 + e]);
                cd0[e] = __builtin_amdgcn_cosf(f0); sd0[e] = __builtin_amdgcn_sinf(f0); cd1[e] = __builtin_amdgcn_cosf(f1); sd1[e] = __builtin_amdgcn_sinf(f1);
            }
        }
        f32x4 c0, s0, c1, s1;
#pragma unroll
        for (int idx = 0; idx < 8; ++idx) {
            const int ai = idx >> 2, m = idx & 3;
            const int r = rbase + ai * HALF + m * 16;
            const float rs = rsv[idx];
            f32x4 x1a = acc[ai][0][m][0] * rs, x1b = acc[ai][0][m][1] * rs, x2a = acc[ai][1][m][0] * rs, x2b = acc[ai][1][m][1] * rs;
            if (rope) {
                if (m == 0) {
                    const float posf = (float)row_pos(r);
#pragma unroll
                    for (int e = 0; e < 4; ++e) {
                        const float f0 = __builtin_amdgcn_fractf(posf * revf[e]), f1 = __builtin_amdgcn_fractf(posf * revf[4 + e]);
                        c0[e] = __builtin_amdgcn_cosf(f0); s0[e] = __builtin_amdgcn_sinf(f0); c1[e] = __builtin_amdgcn_cosf(f1); s1[e] = __builtin_amdgcn_sinf(f1);
                    }
                } else {
                    const f32x4 nc0 = c0 * cd0 - s0 * sd0, ns0 = s0 * cd0 + c0 * sd0, nc1 = c1 * cd1 - s1 * sd1, ns1 = s1 * cd1 + c1 * sd1;
                    c0 = nc0; s0 = ns0; c1 = nc1; s1 = ns1;
                }
                const f32x4 o1a = x1a * c0 - x2a * s0, o2a = x2a * c0 + x1a * s0, o1b = x1b * c1 - x2b * s1, o2b = x2b * c1 + x1b * s1;
                x1a = o1a; x2a = o2a; x1b = o1b; x2b = o2b;
            }
            bf16_t* zr = Z + (size_t)r * INW;
            if (kind == 0) {
                const int c = pn * 256 + wc * 64 + 8 * fq;
                st8bf(zr + c, x1a, x1b); st8bf(zr + c + 32, x2a, x2b);
            } else if (kind == 1) {
                const int cb = pn * 256 + 128 * (wc >> 1) + i0;
                st8bf(zr + cb, x1a, x1b); st8bf(zr + cb + 64, x2a, x2b);
            } else if (kind == 2) {
                const int cb = (pn < 2 ? pn * 256 : 512) + 64 * wc + i0;
                st8bf(zr + cb, x1a, x1b); st8bf(zr + cb + 32, x2a, x2b);
                if (pn == 2) {
                    float* o = nullptr;
                    if (r < MP) { const int t = r & (SEQ - 1); if (t >= SEQ - 128) o = out + O_NKP + ((size_t)((r >> 11) * 128 + (t - (SEQ - 128))) * 2 + wc) * 64 + i0; }
                    else { const int q = r - MP; o = out + O_NKS + ((size_t)((q >> 6) * 128 + 64 + (q & 63)) * 2 + wc) * 64 + i0; }
                    if (o) { *(f32x4*)o = x1a; *(f32x4*)(o + 4) = x1b; *(f32x4*)(o + 32) = x2a; *(f32x4*)(o + 36) = x2b; }
                }
            } else {
                const int d0 = 8 * fq, kvh = wc - 2;
                st8bf(zr + 640 + 64 * kvh + d0, x1a, x1b); st8bf(zr + 640 + 64 * kvh + 32 + d0, x2a, x2b);
                float* o = nullptr;
                if (r < MP) { const int t = r & (SEQ - 1); if (t >= SEQ - 128) o = out + O_NVP + ((size_t)((r >> 11) * 128 + (t - (SEQ - 128))) * 2 + kvh) * 64 + d0; }
                else { const int q = r - MP; o = out + O_NVS + ((size_t)((q >> 6) * 128 + 64 + (q & 63)) * 2 + kvh) * 64 + d0; }
                if (o) { *(f32x4*)o = x1a; *(f32x4*)(o + 4) = x1b; *(f32x4*)(o + 32) = x2a; *(f32x4*)(o + 36) = x2b; }
            }
        }
    }
};
struct EpiOutProj {
    static constexpr bool PERM = true, AFTER_DRAIN = false, LAST_FUSED = false;
    const bf16_t* xn; bf16_t* h1b; float* rowss;
    __device__ __forceinline__ void operator()(const f32x4 (&acc)[2][2][4][2], const Unit& u, int wr, int wc, int fr, int fq) const {
        const int rbase = u.pm * BM + wr * 64 + fr, cbase = u.pn * BM + wc * 64 + 8 * fq;
#pragma unroll
        for (int idx = 0; idx < 8; ++idx) {
            const int ai = idx >> 2, m = idx & 3, r = rbase + ai * HALF + m * 16;
            float ss = 0.f;
#pragma unroll
            for (int bj = 0; bj < 2; ++bj) {
                const u32x4 xb = *(const u32x4*)(xn + (size_t)r * DM + cbase + bj * 32);
                const f32x4 h0 = (f32x4){bflo(xb.x), bfhi(xb.x), bflo(xb.y), bfhi(xb.y)} + acc[ai][bj][m][0], h1 = (f32x4){bflo(xb.z), bfhi(xb.z), bflo(xb.w), bfhi(xb.w)} + acc[ai][bj][m][1];
                ss += ((h0[0] * h0[0] + h0[1] * h0[1]) + (h0[2] * h0[2] + h0[3] * h0[3])) + ((h1[0] * h1[0] + h1[1] * h1[1]) + (h1[2] * h1[2] + h1[3] * h1[3]));
                st8bf(h1b + (size_t)r * DM + cbase + bj * 32, h0, h1);
            }
            ss += __shfl_xor(ss, 16); ss += __shfl_xor(ss, 32);
            if (fq == 0) unsafeAtomicAdd(rowss + (size_t)r * 4 + u.pn, ss);
        }
    }
};
struct EpiOutProjDma {
    static constexpr bool PERM = true, AFTER_DRAIN = true, LAST_FUSED = false;
    const bf16_t* xn; bf16_t* h1b; float* rowss;
    __device__ __forceinline__ void fused(f32x4 (&acc)[2][2][4][2], const Unit& u, int wr, int wc, int fr, int fq, PG8_LAS unsigned char* lds, int wid, int lane) const {
        const int cbase = u.pn * BM + wc * 64 + 8 * fq;
        PG8_LAS float* red = (PG8_LAS float*)(lds + 131072 + 1024);
#pragma unroll
        for (int j = 0; j < 16; ++j) {
            const int rA = wid * 32 + 2 * j, rl = rA + (lane >> 5), chunk = ((lane & 31) + rl) & 31;
            const bf16_t* src = xn + (size_t)(u.pm * BM + rl) * DM + u.pn * BM + chunk * 8;
            __builtin_amdgcn_global_load_lds((const unsigned*)src, (PG8_LAS unsigned*)(lds + rA * 512), 16, 0, 2);
        }
        asm volatile("s_waitcnt vmcnt(0)" ::: "memory"); __builtin_amdgcn_s_barrier(); asm volatile("" ::: "memory");
#pragma unroll
        for (int ai = 0; ai < 2; ++ai) {
#pragma unroll
            for (int m = 0; m < 4; ++m) {
                const int rl = ai * HALF + wr * 64 + m * 16 + fr, r = u.pm * BM + rl;
                float ss = 0.f;
#pragma unroll
                for (int bj = 0; bj < 2; ++bj) {
                    const int pos = (wc * 8 + bj * 4 + fq - rl) & 31;
                    const u32x4 xb = *(const PG8_LAS u32x4*)(lds + rl * 512 + pos * 16);
                    const f32x4 h0 = (f32x4){bflo(xb.x), bfhi(xb.x), bflo(xb.y), bfhi(xb.y)} + acc[ai][bj][m][0], h1 = (f32x4){bflo(xb.z), bfhi(xb.z), bflo(xb.w), bfhi(xb.w)} + acc[ai][bj][m][1];
                    ss += ((h0[0] * h0[0] + h0[1] * h0[1]) + (h0[2] * h0[2] + h0[3] * h0[3])) + ((h1[0] * h1[0] + h1[1] * h1[1]) + (h1[2] * h1[2] + h1[3] * h1[3]));
                    st8bf(h1b + (size_t)r * DM + cbase + bj * 32, h0, h1);
                }
                ss += __shfl_xor(ss, 16); ss += __shfl_xor(ss, 32);
                if (fq == 0) red[(wr * 64 + m * 16 + fr) * 4 + wc] = ss;
            }
            asm volatile("s_waitcnt lgkmcnt(0)" ::: "memory"); __builtin_amdgcn_s_barrier(); asm volatile("" ::: "memory");
            { const int t = wid * 64 + lane; if (t < HALF) rowss[(size_t)(u.pm * BM + ai * HALF + t) * 4 + u.pn] = (red[t * 4] + red[t * 4 + 1]) + (red[t * 4 + 2] + red[t * 4 + 3]); }
            asm volatile("s_waitcnt lgkmcnt(0)" ::: "memory"); __builtin_amdgcn_s_barrier(); asm volatile("" ::: "memory");
        }
    }
};
struct EpiUp {
    static constexpr bool PERM = true, AFTER_DRAIN = false, LAST_FUSED = false;
    const float* rowss; bf16_t* U;
    __device__ __forceinline__ void operator()(const f32x4 (&acc)[2][2][4][2], const Unit& u, int wr, int wc, int fr, int fq) const {
        float rsv[8];
#pragma unroll
        for (int idx = 0; idx < 8; ++idx) { const f32x4 q = *(const f32x4*)(rowss + (size_t)(u.pm * BM + (idx >> 2) * HALF + wr * 64 + (idx & 3) * 16 + fr) * 4); rsv[idx] = (q[0] + q[1]) + (q[2] + q[3]); }
#pragma unroll
        for (int ai = 0; ai < 2; ++ai)
#pragma unroll
            for (int m = 0; m < 4; ++m) {
                const int r = u.pm * BM + ai * HALF + wr * 64 + m * 16 + fr;
                const float rs = rsqrtf(rsv[ai * 4 + m] * (1.0f / DM) + EPS);
#pragma unroll
                for (int bj = 0; bj < 2; ++bj) {
                    f32x4 a = acc[ai][bj][m][0] * rs, b = acc[ai][bj][m][1] * rs;
#pragma unroll
                    for (int t = 0; t < 4; ++t) { a[t] = fmaxf(a[t], 0.f); a[t] *= a[t]; b[t] = fmaxf(b[t], 0.f); b[t] *= b[t]; }
                    st8bf(U + (size_t)r * FF + u.pn * BM + wc * 64 + bj * 32 + 8 * fq, a, b);
                }
            }
    }
};
struct EpiDownNorm {
    static constexpr bool PERM = true, AFTER_DRAIN = false, LAST_FUSED = true;
    const bf16_t* h1b; float* y; bf16_t* slab; const float* normf; float* xbuf; unsigned* cnt;
    __device__ __forceinline__ void operator()(f32x4 (&acc)[2][2][4][2], const Unit& u, int wr, int wc, int fr, int fq) const {
#pragma unroll
        for (int ai = 0; ai < 2; ++ai)
#pragma unroll
            for (int m = 0; m < 4; ++m) {
                const int r = u.pm * BM + ai * HALF + wr * 64 + m * 16 + fr;
#pragma unroll
                for (int bj = 0; bj < 2; ++bj)
                    st8bf(slab + (size_t)(u.k0 / u.nt) * ((size_t)MS * DM) + (size_t)(r - MP) * DM + u.pn * BM + wc * 64 + bj * 32 + 8 * fq, acc[ai][bj][m][0], acc[ai][bj][m][1]);
            }
    }
    __device__ __forceinline__ void fused(f32x4 (&acc)[2][2][4][2], const Unit& u, int wr, int wc, int fr, int fq, PG8_LAS unsigned char* lds, int wid, int lane) const {
        if (u.nt != FF / BK) { (*this)(acc, u, wr, wc, fr, fq); return; }
        PG8_LAS float* Pp = (PG8_LAS float*)(lds + 131072 + 1024); PG8_LAS float* Sr = (PG8_LAS float*)(lds + 131072 + 1024 + 4096);
        const int tid = wid * 64 + lane;
#pragma unroll
        for (int j = 0; j < 16; ++j) {
            const int rA = wid * 32 + 2 * j, rl = rA + (lane >> 5), chunk = ((lane & 31) + rl) & 31;
            const bf16_t* src = h1b + (size_t)(u.pm * BM + rl) * DM + u.pn * BM + chunk * 8;
            __builtin_amdgcn_global_load_lds((const unsigned*)src, (PG8_LAS unsigned*)(lds + rA * 512), 16, 0, 2);
        }
        asm volatile("s_waitcnt vmcnt(0)" ::: "memory"); __builtin_amdgcn_s_barrier(); asm volatile("" ::: "memory");
#pragma unroll
        for (int ai = 0; ai < 2; ++ai)
#pragma unroll
            for (int m = 0; m < 4; ++m) {
                const int rl = ai * HALF + wr * 64 + m * 16 + fr;
                float ss = 0.f;
#pragma unroll
                for (int bj = 0; bj < 2; ++bj) {
                    const int pos = (wc * 8 + bj * 4 + fq - rl) & 31;
                    const u32x4 xb = *(const PG8_LAS u32x4*)(lds + rl * 512 + pos * 16);
                    const f32x4 h0 = acc[ai][bj][m][0] + (f32x4){bflo(xb.x), bfhi(xb.x), bflo(xb.y), bfhi(xb.y)}, h1 = acc[ai][bj][m][1] + (f32x4){bflo(xb.z), bfhi(xb.z), bflo(xb.w), bfhi(xb.w)};
                    acc[ai][bj][m][0] = h0; acc[ai][bj][m][1] = h1;
                    ss += ((h0[0] * h0[0] + h0[1] * h0[1]) + (h0[2] * h0[2] + h0[3] * h0[3])) + ((h1[0] * h1[0] + h1[1] * h1[1]) + (h1[2] * h1[2] + h1[3] * h1[3]));
                }
                ss += __shfl_xor(ss, 16); ss += __shfl_xor(ss, 32);
                if (fq == 0) Pp[rl * 4 + wc] = ss;
            }
        asm volatile("s_waitcnt lgkmcnt(0)" ::: "memory"); __builtin_amdgcn_s_barrier(); asm volatile("" ::: "memory");
        if (tid < 256) {
            const float t = (Pp[tid * 4] + Pp[tid * 4 + 1]) + (Pp[tid * 4 + 2] + Pp[tid * 4 + 3]);
            __hip_atomic_store(xbuf + ((size_t)(u.pm * BM + tid) * 4 + u.pn), t, __ATOMIC_RELAXED, __HIP_MEMORY_SCOPE_AGENT);
        }
        asm volatile("s_waitcnt vmcnt(0)" ::: "memory");
        __builtin_amdgcn_s_barrier(); asm volatile("" ::: "memory");
        if (tid == 0) {
            unsigned* cw = cnt + 64 * u.pm;
            __hip_atomic_fetch_add(cw, 1u, __ATOMIC_RELAXED, __HIP_MEMORY_SCOPE_AGENT);
            unsigned sp = 0;
            while (__hip_atomic_load(cw, __ATOMIC_RELAXED, __HIP_MEMORY_SCOPE_AGENT) < 4u) { __builtin_amdgcn_s_sleep(2); if (++sp > (1u << 20)) break; }
            __builtin_amdgcn_fence(__ATOMIC_ACQUIRE, "agent");
        }
        asm volatile("s_waitcnt vmcnt(0) lgkmcnt(0)" ::: "memory"); __builtin_amdgcn_s_barrier(); asm volatile("" ::: "memory");
        if (tid < 256) {
            const float* slot = xbuf + (size_t)(u.pm * BM + tid) * 4;
            const float t = (__hip_atomic_load(slot, __ATOMIC_RELAXED, __HIP_MEMORY_SCOPE_AGENT) + __hip_atomic_load(slot + 1, __ATOMIC_RELAXED, __HIP_MEMORY_SCOPE_AGENT))
                          + (__hip_atomic_load(slot + 2, __ATOMIC_RELAXED, __HIP_MEMORY_SCOPE_AGENT) + __hip_atomic_load(slot + 3, __ATOMIC_RELAXED, __HIP_MEMORY_SCOPE_AGENT));
            Sr[tid] = rsqrtf(t * (1.0f / DM) + EPS);
        }
        asm volatile("s_waitcnt lgkmcnt(0)" ::: "memory"); __builtin_amdgcn_s_barrier(); asm volatile("" ::: "memory");
        f32x4 nf[2][2];
#pragma unroll
        for (int bj = 0; bj < 2; ++bj)
#pragma unroll
            for (int n = 0; n < 2; ++n) nf[bj][n] = *(const f32x4*)(normf + u.pn * BM + wc * 64 + bj * 32 + n * 4 + 8 * fq);
#pragma unroll
        for (int ai = 0; ai < 2; ++ai)
#pragma unroll
            for (int m = 0; m < 4; ++m) {
                const int rl = ai * HALF + wr * 64 + m * 16 + fr; const size_t row = (size_t)(u.pm * BM + rl);
                const float rs = Sr[rl];
#pragma unroll
                for (int bj = 0; bj < 2; ++bj)
#pragma unroll
                    for (int n = 0; n < 2; ++n)
                        *(f32x4*)(y + row * DM + u.pn * BM + wc * 64 + bj * 32 + n * 4 + 8 * fq) = acc[ai][bj][m][n] * rs * nf[bj][n];
            }
    }
};
template <class Epi, class Sched, bool ALIGN_EPI = false, bool SP2 = false, int AUXA = 0>
__device__ __forceinline__ void gemm_phase(PG8_LAS unsigned char* lds, const Gemm g, const Sched& S, const Epi& E, int wave0) {
    const int tid = tid_of(wave0), wid = wave0, lane = tid & 63, wr = wid >> 2, wc = wid & 3, fr = lane & 15, fq = lane >> 4;
    const int K = g.K;
    unsigned voffA[2], voffB[2];
#pragma unroll
    for (int i = 0; i < 2; ++i) { int R, C; stage_rc(tid * 16 + i * 8192, R, C); const int Rb = (R >> 5) * 64 + (Epi::PERM ? perm32(R & 31) : (R & 31));
        voffA[i] = (unsigned)(R * K + C) * 2u; voffB[i] = (unsigned)(Rb * K + C) * 2u; }
    const size_t kstep = (size_t)(BK * 2);
    const size_t hstep = (size_t)HALF * K * 2;
    const size_t tstep = 2 * hstep;
    const size_t hstepB = (size_t)32 * K * 2;
    const unsigned ldsw = (unsigned)wid * 1024u;
    const int aoff = lds_byte(wr * 64 + fr, fq * 8), boff = lds_byte(wc * 32 + fr, fq * 8);
#define PG8_SA(b, h) (((b) * 2 + (h)) * HTB)
#define PG8_SB(b, h) ((4 + (b) * 2 + (h)) * HTB)
#define PG8_STAGE(bufoff, gbase, voff) do { _Pragma("unroll") for (int _i = 0; _i < 2; ++_i) \
        __builtin_amdgcn_global_load_lds((const unsigned*)((const char*)(gbase) + (voff)[_i]), (PG8_LAS unsigned*)(lds + (bufoff) + ldsw + _i * 8192), 16, 0, 0); } while (0)
#define PG8_STAGEA(bufoff, gbase, voff) do { _Pragma("unroll") for (int _i = 0; _i < 2; ++_i) \
        __builtin_amdgcn_global_load_lds((const unsigned*)((const char*)(gbase) + (voff)[_i]), (PG8_LAS unsigned*)(lds + (bufoff) + ldsw + _i * 8192), 16, 0, AUXA); } while (0)
#define PG8_LDA(dst, b, h) do { _Pragma("unroll") for (int m = 0; m < 4; ++m) _Pragma("unroll") for (int k = 0; k < 2; ++k) dst[m][k] = *(const PG8_LAS bf16x8*)(lds + PG8_SA(b, h) + aoff + m * 2048 + k * 1024); } while (0)
#define PG8_LDB(dst, b, h) do { _Pragma("unroll") for (int n = 0; n < 2; ++n) _Pragma("unroll") for (int k = 0; k < 2; ++k) dst[n][k] = *(const PG8_LAS bf16x8*)(lds + PG8_SB(b, h) + boff + n * 2048 + k * 1024); } while (0)
#define PG8_MMA(ai, bj, At, Bt) do { __builtin_amdgcn_s_setprio(1); _Pragma("unroll") for (int m = 0; m < 4; ++m) _Pragma("unroll") for (int n = 0; n < 2; ++n) _Pragma("unroll") for (int k = 0; k < 2; ++k) \
        acc[ai][bj][m][n] = __builtin_amdgcn_mfma_f32_16x16x32_bf16(Bt[n][k], At[m][k], acc[ai][bj][m][n], 0, 0, 0); __builtin_amdgcn_s_setprio(0); } while (0)
#define PG8_WAIT_V(n) asm volatile("s_waitcnt vmcnt(" #n ")" ::: "memory")
#define PG8_WAIT_L(n) asm volatile("s_waitcnt lgkmcnt(" #n ")" ::: "memory")
#define PG8_BAR __builtin_amdgcn_s_barrier()
#define PG8_SCHED __builtin_amdgcn_sched_barrier(0)
    Unit cur, nxt; int ui = 0;
    if (!S.next(0, cur)) return;
    f32x4 acc[2][2][4][2];
#pragma unroll
    for (int a = 0; a < 2; ++a)
#pragma unroll
        for (int b = 0; b < 2; ++b)
#pragma unroll
            for (int m = 0; m < 4; ++m)
#pragma unroll
                for (int n = 0; n < 2; ++n) acc[a][b][m][n] = (f32x4){0.f, 0.f, 0.f, 0.f};
    bf16x8 At[4][2], B0[2][2], B1[2][2];
    const char* cA = (const char*)g.A + (size_t)cur.pm * tstep + (size_t)cur.k0 * (BK * 2); const char* cB = (const char*)g.Bt + (size_t)cur.pn * tstep + (size_t)cur.k0 * (BK * 2);
    S.a_ready(cur);
    if constexpr (SP2) {
        PG8_STAGE(PG8_SB(0, 0), cB, voffB); PG8_STAGE(PG8_SB(0, 1), cB + hstepB, voffB); PG8_STAGEA(PG8_SA(0, 0), cA, voffA); PG8_STAGEA(PG8_SA(0, 1), cA + hstep, voffA);
        if (wr == 1) PG8_BAR;
        PG8_WAIT_V(2); PG8_BAR;
        PG8_STAGE(PG8_SB(1, 0), cB + kstep, voffB); PG8_STAGEA(PG8_SA(1, 0), cA + kstep, voffA); PG8_STAGE(PG8_SB(1, 1), cB + hstepB + kstep, voffB);
        PG8_WAIT_V(6); PG8_BAR;
    } else {
        PG8_STAGE(PG8_SB(0, 0), cB, voffB); PG8_STAGEA(PG8_SA(0, 0), cA, voffA); PG8_STAGE(PG8_SB(0, 1), cB + hstepB, voffB); PG8_STAGEA(PG8_SA(0, 1), cA + hstep, voffA);
        if (wr == 1) PG8_BAR;
        PG8_WAIT_V(4); PG8_BAR;
        PG8_STAGE(PG8_SB(1, 0), cB + kstep, voffB); PG8_STAGEA(PG8_SA(1, 0), cA + kstep, voffA); PG8_STAGE(PG8_SB(1, 1), cB + hstepB + kstep, voffB);
        PG8_WAIT_V(6); PG8_BAR;
    }
    for (;;) {
        const bool has_next = S.next(ui + 1, nxt);
        const char* nA = has_next ? (const char*)g.A + (size_t)nxt.pm * tstep + (size_t)nxt.k0 * (BK * 2) : cA; const char* nB = has_next ? (const char*)g.Bt + (size_t)nxt.pn * tstep + (size_t)nxt.k0 * (BK * 2) : cB;
        const int nt = cur.nt;
        for (int t = 0; t < nt; t += 2) {
            const bool last = (t == nt - 2);
            const char* a1 = cA + (size_t)(t + 1) * kstep;
            const char* a2 = last ? nA : cA + (size_t)(t + 2) * kstep; const char* b2 = last ? nB : cB + (size_t)(t + 2) * kstep;
            const char* a3 = a2 + kstep; const char* b3 = b2 + kstep;
            if (last && has_next) S.a_ready(nxt);
            if constexpr (SP2) {
            PG8_LDB(B0, 0, 0); PG8_LDB(B1, 0, 1); PG8_SCHED; PG8_LDA(At, 0, 0); PG8_STAGEA(PG8_SA(1, 1), a1 + hstep, voffA);
            PG8_WAIT_V(8); PG8_WAIT_L(0); PG8_BAR; PG8_MMA(0, 0, At, B0); PG8_MMA(0, 1, At, B1); PG8_BAR; PG8_SCHED;
            PG8_LDA(At, 0, 1); PG8_STAGE(PG8_SB(0, 0), b2, voffB); PG8_STAGE(PG8_SB(0, 1), b2 + hstepB, voffB); PG8_STAGEA(PG8_SA(0, 0), a2, voffA);
            PG8_WAIT_V(8); PG8_WAIT_L(0); PG8_BAR; PG8_MMA(1, 0, At, B0); PG8_MMA(1, 1, At, B1); PG8_BAR; PG8_SCHED;
            PG8_LDB(B0, 1, 0); PG8_LDB(B1, 1, 1); PG8_SCHED; PG8_LDA(At, 1, 0); PG8_STAGEA(PG8_SA(0, 1), a2 + hstep, voffA);
            PG8_WAIT_V(8); PG8_WAIT_L(0); PG8_BAR; PG8_MMA(0, 0, At, B0); PG8_MMA(0, 1, At, B1); PG8_BAR; PG8_SCHED;
            PG8_LDA(At, 1, 1); PG8_STAGE(PG8_SB(1, 0), b3, voffB); PG8_STAGE(PG8_SB(1, 1), b3 + hstepB, voffB); PG8_STAGEA(PG8_SA(1, 0), a3, voffA);
            PG8_WAIT_V(8); PG8_WAIT_L(0); PG8_BAR; PG8_MMA(1, 0, At, B0); PG8_MMA(1, 1, At, B1); PG8_BAR; PG8_SCHED;
            } else {
            PG8_LDB(B0, 0, 0); PG8_SCHED; PG8_LDA(At, 0, 0); PG8_STAGEA(PG8_SA(1, 1), a1 + hstep, voffA);
            PG8_WAIT_L(8); PG8_BAR; PG8_WAIT_L(0); PG8_MMA(0, 0, At, B0); PG8_BAR; PG8_SCHED;
            PG8_LDB(B1, 0, 1); PG8_STAGE(PG8_SB(0, 0), b2, voffB);
            PG8_BAR; PG8_WAIT_L(0); PG8_MMA(0, 1, At, B1); PG8_BAR;
            PG8_LDA(At, 0, 1); PG8_STAGEA(PG8_SA(0, 0), a2, voffA);
            PG8_BAR; PG8_WAIT_L(0); PG8_MMA(1, 0, At, B0); PG8_BAR; PG8_SCHED;
            PG8_STAGE(PG8_SB(0, 1), b2 + hstepB, voffB);
            PG8_WAIT_V(6); PG8_BAR; PG8_MMA(1, 1, At, B1); PG8_BAR;
            PG8_LDB(B0, 1, 0); PG8_SCHED; PG8_LDA(At, 1, 0); PG8_STAGEA(PG8_SA(0, 1), a2 + hstep, voffA);
            PG8_WAIT_L(8); PG8_BAR; PG8_WAIT_L(0); PG8_MMA(0, 0, At, B0); PG8_BAR; PG8_SCHED;
            PG8_LDB(B1, 1, 1); PG8_STAGE(PG8_SB(1, 0), b3, voffB);
            PG8_BAR; PG8_WAIT_L(0); PG8_MMA(0, 1, At, B1); PG8_BAR;
            PG8_LDA(At, 1, 1); PG8_STAGEA(PG8_SA(1, 0), a3, voffA);
            PG8_BAR; PG8_WAIT_L(0); PG8_MMA(1, 0, At, B0); PG8_BAR; PG8_SCHED;
            PG8_STAGE(PG8_SB(1, 1), b3 + hstepB, voffB);
            PG8_WAIT_V(6); PG8_BAR; PG8_MMA(1, 1, At, B1); PG8_BAR;
            }
        }
        if constexpr (ALIGN_EPI) { if (wr == 0) PG8_BAR; }
        if constexpr (!Epi::AFTER_DRAIN) { if (!(Epi::LAST_FUSED && !has_next)) { E(acc, cur, wr, wc, fr, fq); S.done(cur); } }
        if (!has_next) break;
#pragma unroll
        for (int a = 0; a < 2; ++a)
#pragma unroll
            for (int b = 0; b < 2; ++b)
#pragma unroll
                for (int m = 0; m < 4; ++m)
#pragma unroll
                    for (int n = 0; n < 2; ++n) acc[a][b][m][n] = (f32x4){0.f, 0.f, 0.f, 0.f};
        cur = nxt; cA = nA; cB = nB; ++ui;
        if constexpr (ALIGN_EPI) { if (wr == 1) PG8_BAR; }
    }
    PG8_WAIT_V(0);
    if constexpr (!ALIGN_EPI) { if (wr == 0) PG8_BAR; }
    PG8_BAR;
    if constexpr (Epi::AFTER_DRAIN || Epi::LAST_FUSED) { E.fused(acc, cur, wr, wc, fr, fq, lds, wid, lane); S.done(cur); }
#undef PG8_SA
#undef PG8_SB
#undef PG8_STAGE
#undef PG8_STAGEA
#undef PG8_LDA
#undef PG8_LDB
#undef PG8_MMA
#undef PG8_WAIT_V
#undef PG8_WAIT_L
#undef PG8_BAR
#undef PG8_SCHED
}
}

DI void st8(bf16_t* p, u32x2 w, bool wt) {
    if (wt) __hip_atomic_store((unsigned long long*)p, ((unsigned long long)w.y << 32) | w.x, __ATOMIC_RELAXED, __HIP_MEMORY_SCOPE_AGENT);
    else *(u32x2*)p = w;
}
DI float wave_sum(float v) {
#pragma unroll
    for (int o = 1; o < 64; o <<= 1) v += __shfl_xor(v, o);
    return v;
}
DI int win_perm(int n) {
    if (n >= 768 && n < 1792) { const int r = n & 255, hl = r >> 7, half = (r >> 6) & 1, q = (r >> 5) & 1; return (n & ~255) + 64 * (2 * hl + q) + 32 * half + (r & 31); }
    return n;
}
DI void p0_transpose_item(const float* W, int K, int N, bf16_t* WT, const float* gain, bool is_win, LAS float* scr, int item, int lane) {
    const int nblk = N / 32, kb = item / nblk, nb = item % nblk, k0 = 64 * kb, n0 = 32 * nb;
    float cs = 1.f; int prow = n0;
    if (is_win) { prow = win_perm(n0); if (n0 < 512) cs = 0.125f; else if (n0 >= 1280 && n0 < 1792) cs = 0.08838834764831845f; }
#pragma unroll 8
    for (int i = 0; i < 32; ++i) { const int kk = 2 * i + (lane >> 5); float w = __builtin_nontemporal_load(W + (size_t)(k0 + kk) * N + n0 + (lane & 31)) * cs;     if (gain) w *= gain[k0 + kk]; scr[kk * 33 + (lane & 31)] = w; }
    asm volatile("s_waitcnt lgkmcnt(0)" ::: "memory");
    const int c = lane & 7;
#pragma unroll
    for (int j = 0; j < 4; ++j) { const int n = (lane >> 3) + 8 * j; const LAS float* s = scr + (8 * c) * 33 + n;
        u32x4 o; o.x = pk(s[0 * 33], s[1 * 33]); o.y = pk(s[2 * 33], s[3 * 33]); o.z = pk(s[4 * 33], s[5 * 33]); o.w = pk(s[6 * 33], s[7 * 33]);
        *(u32x4*)(WT + (size_t)(prow + n) * K + k0 + 8 * c) = o; }
    asm volatile("s_waitcnt lgkmcnt(0)" ::: "memory");
}
DI void p0_prologue(const Params& P, lds_t* lds, int G, int tid, int wave, int lane, bool late_ffn) {
    unsigned char* ws = P.ws;
    LAS float* scr = (LAS float*)(lds + wave * 16384);
    const int gw = blockIdx.x * 8 + wave, NGW = G * 8;
    constexpr int I_IN = (DM / 64) * (INW / 32), I_OUT = (DM / 64) * (DM / 32), I_UP = (DM / 64) * (FF / 32), I_DN = (FF / 64) * (DM / 32);
    const int n_items = late_ffn ? I_IN + I_OUT : I_IN + I_OUT + I_UP + I_DN;
    for (int it = gw; it < n_items; it += NGW) {
        int r = it;
        if (r < I_IN) { p0_transpose_item(P.w_in, DM, INW, (bf16_t*)(ws + WS_WIN), P.norm1, true, scr, r, lane); continue; } r -= I_IN;
        if (r < I_OUT) { p0_transpose_item(P.w_out, DM, DM, (bf16_t*)(ws + WS_WOUT), nullptr, false, scr, r, lane); continue; } r -= I_OUT;
        if (r < I_UP) { p0_transpose_item(P.w_up, DM, FF, (bf16_t*)(ws + WS_WUP), P.norm2, false, scr, r, lane); continue; } r -= I_UP;
        p0_transpose_item(P.w_down, FF, DM, (bf16_t*)(ws + WS_WDN), nullptr, false, scr, r, lane);
    }
    bf16_t* XN = (bf16_t*)(ws + WS_XN); float* rs1 = (float*)(ws + WS_RS1);
    for (int m = gw; m < MT; m += NGW) {
        const float* xr = m < MP ? P.xp + (size_t)m * DM : P.xs + (size_t)(m - MP) * DM;
        f32x4 v[4]; float s = 0.f;
#pragma unroll
        for (int j = 0; j < 4; ++j) { v[j] = __builtin_nontemporal_load((const f32x4*)(xr + 4 * lane + 256 * j)); s += (v[j][0] * v[j][0] + v[j][1] * v[j][1]) + (v[j][2] * v[j][2] + v[j][3] * v[j][3]); }
        s = wave_sum(s);
        if (lane == 0) rs1[m] = rsqrtf(s * (1.0f / DM) + EPS);
#pragma unroll
        for (int j = 0; j < 4; ++j) { u32x2 w = {pk(v[j][0], v[j][1]), pk(v[j][2], v[j][3])}; *(u32x2*)(XN + (size_t)m * DM + 4 * lane + 256 * j) = w; }
    }
    const int gt = blockIdx.x * 512 + tid, NGT = G * 512;
    for (int e = gt; e < MT * 4; e += NGT) ((float*)(ws + WS_ROWSS2))[e] = 0.f;
    for (int e = gt; e < 2 * DB * 2048; e += NGT) {
        const int which = e / (DB * 2048), q = e % (DB * 2048), b = q >> 11, o4 = (q & 2047) * 4;
        const float* src = (which ? P.cache_v : P.cache_k) + (size_t)b * 16384 + 8192 + o4;
        float* dst = P.out + (which ? O_NVS : O_NKS) + (size_t)b * 16384 + o4;
        *(f32x4*)dst = __builtin_nontemporal_load((const f32x4*)src);
    }
}

DI void p2_ffn_weights(const Params& P, lds_t* lds, int GP, int bx, int wave, int lane) {
    unsigned char* ws = P.ws;
    LAS float* scr = (LAS float*)(lds + wave * 16384);
    constexpr int I_UP = (DM / 64) * (FF / 32), I_DN = (FF / 64) * (DM / 32);
    for (int it = bx * 8 + wave; it < I_UP + I_DN; it += GP * 8) {
        if (it < I_UP) p0_transpose_item(P.w_up, DM, FF, (bf16_t*)(ws + WS_WUP), P.norm2, false, scr, it, lane);
        else p0_transpose_item(P.w_down, FF, DM, (bf16_t*)(ws + WS_WDN), nullptr, false, scr, it - I_UP, lane);
    }
}

DI void attn_decode(int unit, bool& samp, int& b, int& kvh, int& c) {
    samp = unit >= 512;
    if (!samp) { b = unit >> 6; kvh = (unit >> 5) & 1; c = unit & 31; } else { const int u2 = unit - 512; b = u2 >> 1; kvh = u2 & 1; c = 2; }
}
DI void attn_qload(const bf16_t* Z, bool samp, int b, int kvh, int c, int wave, int lane, bf16x8 (&qf)[2][2]) {
    const int g = lane >> 4, l15 = lane & 15, head = 4 * kvh + (wave >> 1), t0 = 32 * (wave & 1);
    const int qrow0 = (samp ? MP + 64 * b : b * SEQ + 64 * c) + t0;
#pragma unroll
    for (int qt = 0; qt < 2; ++qt)
#pragma unroll
        for (int ks = 0; ks < 2; ++ks) qf[qt][ks] = *(const bf16x8*)(Z + (size_t)(qrow0 + 16 * qt + l15) * INW + 64 * head + 32 * ks + 8 * g);
}
DI void attn_compute(lds_t* lds, const Params& P, bool samp, int b, int kvh, int c, int wave, int lane, const bf16x8 (&qf)[2][2]) {
    bf16_t* MIX = (bf16_t*)(P.ws + WS_MIX);
    lds_t* Ks = lds; lds_t* Vs = lds + 192 * 144;
    const int g = lane >> 4, l15 = lane & 15;
    const int head = 4 * kvh + (wave >> 1), t0 = 32 * (wave & 1);
    const int qrow0 = (samp ? MP + 64 * b : b * SEQ + 64 * c) + t0;
    const int kt0 = samp ? 0 : (c >= 2 ? 0 : (c == 1 ? 4 : 8));
    const float sink = P.sinks[head] * 1.4426950408889634f;
    f32x4 s[12][2];
#pragma unroll
    for (int kt = 0; kt < 12; ++kt) {
        const bf16x8 k0 = frag_N(Ks, 144, 16 * kt, 0, lane), k1 = frag_N(Ks, 144, 16 * kt, 32, lane);
#pragma unroll
        for (int qt = 0; qt < 2; ++qt) { f32x4 a = {0.f, 0.f, 0.f, 0.f}; a = mfma16(k0, qf[qt][0], a); a = mfma16(k1, qf[qt][1], a); s[kt][qt] = a; }
    }
    float inv[2];
#pragma unroll
    for (int qt = 0; qt < 2; ++qt) {
        float mx = -INFINITY;
#pragma unroll
        for (int kt = 0; kt < 12; ++kt)
#pragma unroll
            for (int i = 0; i < 4; ++i) { s[kt][qt][i] = (kt < kt0) ? -INFINITY : s[kt][qt][i] * 1.4426950408889634f; mx = fmaxf(mx, s[kt][qt][i]); }
        mx = fmaxf(mx, __shfl_xor(mx, 16)); mx = fmaxf(mx, __shfl_xor(mx, 32));
        mx = fmaxf(mx, sink);
        float sum = 0.f;
#pragma unroll
        for (int kt = 0; kt < 12; ++kt)
#pragma unroll
            for (int i = 0; i < 4; ++i) { const float p = __builtin_amdgcn_exp2f(s[kt][qt][i] - mx); s[kt][qt][i] = p; sum += p; }
        sum += __shfl_xor(sum, 16); sum += __shfl_xor(sum, 32);
        sum += __builtin_amdgcn_exp2f(sink - mx);
        inv[qt] = 1.0f / sum;
    }
#pragma unroll
    for (int dt = 0; dt < 4; ++dt) {
        f32x4 o0 = {0.f, 0.f, 0.f, 0.f}, o1 = {0.f, 0.f, 0.f, 0.f};
#pragma unroll
        for (int kk = 0; kk < 6; ++kk) { const bf16x8 vf = frag_Tp(Vs, 144, 32 * kk, 16 * dt, lane); o0 = mfma16(vf, pack8(s[2 * kk][0], s[2 * kk + 1][0]), o0); o1 = mfma16(vf, pack8(s[2 * kk][1], s[2 * kk + 1][1]), o1); }
        o0 = o0 * inv[0]; o1 = o1 * inv[1];
        const int col = 64 * head + 16 * dt + 4 * g;
        u32x2 w0 = {pk(o0[0], o0[1]), pk(o0[2], o0[3])}, w1 = {pk(o1[0], o1[1]), pk(o1[2], o1[3])};
        st8(MIX + (size_t)(qrow0 + l15) * DM + col, w0, samp);
        st8(MIX + (size_t)(qrow0 + 16 + l15) * DM + col, w1, samp);
    }
}
struct AttnRegs { u32x4 k[3], v[3]; bf16x8 q[2][2]; };
DI void attn_load(const bf16_t* Z, int unit, int tid, int wave, int lane, AttnRegs& R) {
    bool samp; int b, kvh, c; attn_decode(unit, samp, b, kvh, c);
#pragma unroll
    for (int i = 0; i < 3; ++i) {
        const int v = tid + 512 * i, key = v >> 3, d0 = (v & 7) * 8, pos = 64 * (c - 2) + key;
        R.k[i] = (u32x4){0u, 0u, 0u, 0u}; R.v[i] = (u32x4){0u, 0u, 0u, 0u};
        if (pos >= 0) { const bf16_t* zr = Z + (size_t)(b * SEQ + pos) * INW; R.k[i] = *(const u32x4*)(zr + 512 + 64 * kvh + d0); R.v[i] = *(const u32x4*)(zr + 640 + 64 * kvh + d0); }
    }
    attn_qload(Z, false, b, kvh, c, wave, lane, R.q);
}
DI void attn_prompt_loop(lds_t* lds, const Params& P, int G, int bx, int tid, int wave, int lane) {
    const bf16_t* Z = (const bf16_t*)(P.ws + WS_Z);
    lds_t* Ks = lds; lds_t* Vs = lds + 192 * 144;
    AttnRegs R;
    int u = bx;
    if (u < 512) attn_load(Z, u, tid, wave, lane, R);
    for (; u < 512; u += G) {
#pragma unroll
        for (int i = 0; i < 3; ++i) { const int v = tid + 512 * i, key = v >> 3, d0 = (v & 7) * 8; *(LAS u32x4*)(Ks + key * 144 + d0 * 2) = R.k[i]; *(LAS u32x4*)(Vs + key * 144 + d0 * 2) = R.v[i]; }
        bf16x8 qf[2][2];
#pragma unroll
        for (int qt = 0; qt < 2; ++qt)
#pragma unroll
            for (int ks = 0; ks < 2; ++ks) qf[qt][ks] = R.q[qt][ks];
        __syncthreads();
        if (u + G < 512) attn_load(Z, u + G, tid, wave, lane, R);
        bool samp; int b, kvh, c; attn_decode(u, samp, b, kvh, c);
        attn_compute(lds, P, false, b, kvh, c, wave, lane, qf);
        __syncthreads();
    }
}
DI void attn_unit(lds_t* lds, const Params& P, int unit, int tid, int wave, int lane) {
    const bf16_t* Z = (const bf16_t*)(P.ws + WS_Z);
    const bool samp = unit >= 512;
    int b, kvh, c;
    if (!samp) { b = unit >> 6; kvh = (unit >> 5) & 1; c = unit & 31; } else { const int u2 = unit - 512; b = u2 >> 1; kvh = u2 & 1; c = 2; }
    lds_t* Ks = lds; lds_t* Vs = lds + 192 * 144;
    for (int v = tid; v < 1536; v += 512) {
        const int key = v >> 3, d0 = (v & 7) * 8;
        u32x4 kv = {0u, 0u, 0u, 0u}, vv = {0u, 0u, 0u, 0u};
        if (samp && key < 128) {
            const size_t off = ((size_t)(b * 128 + key) * 2 + kvh) * 64 + d0;
            const f32x4 a = *(const f32x4*)(P.cache_k + off), a2 = *(const f32x4*)(P.cache_k + off + 4);
            const f32x4 e = *(const f32x4*)(P.cache_v + off), e2 = *(const f32x4*)(P.cache_v + off + 4);
            kv = (u32x4){pk(a[0], a[1]), pk(a[2], a[3]), pk(a2[0], a2[1]), pk(a2[2], a2[3])};
            vv = (u32x4){pk(e[0], e[1]), pk(e[2], e[3]), pk(e2[0], e2[1]), pk(e2[2], e2[3])};
        } else {
            int row = -1;
            if (samp) row = MP + 64 * b + key - 128; else { const int pos = 64 * (c - 2) + key; if (pos >= 0) row = b * SEQ + pos; }
            if (row >= 0) { const bf16_t* zr = Z + (size_t)row * INW; kv = *(const u32x4*)(zr + 512 + 64 * kvh + d0); vv = *(const u32x4*)(zr + 640 + 64 * kvh + d0); }
        }
        *(LAS u32x4*)(Ks + key * 144 + d0 * 2) = kv; *(LAS u32x4*)(Vs + key * 144 + d0 * 2) = vv;
    }
    __syncthreads();
    bf16x8 qf[2][2];
    attn_qload(Z, samp, b, kvh, c, wave, lane, qf);
    attn_compute(lds, P, samp, b, kvh, c, wave, lane, qf);
    __syncthreads();
}

DI void ret_decode(int ru, bool& samp, int& b, int& c, int& h, int& row0) {
    samp = ru >= 1024; h = ru & 3;
    if (!samp) { b = ru >> 7; c = (ru >> 2) & 31; row0 = b * SEQ + 64 * c; } else { b = (ru - 1024) >> 2; c = 0; row0 = MP + 64 * b; }
}
DI float log2_gamma(int h) { return log2f(1.0f - exp2f(-5.0f - (float)h)); }

struct KvRegs { u32x4 k[2], v[2]; };
DI void retkv_load(const bf16_t* Z, int ru, int tid, KvRegs& R) {
    bool samp; int b, c, h, row0; ret_decode(ru, samp, b, c, h, row0);
#pragma unroll
    for (int i = 0; i < 2; ++i) { const int v = tid + 512 * i, j = v >> 4, d0 = (v & 15) * 8; const bf16_t* zr = Z + (size_t)(row0 + j) * INW;
        R.k[i] = *(const u32x4*)(zr + 1280 + 128 * h + d0); R.v[i] = *(const u32x4*)(zr + 1792 + 128 * h + d0); }
}
DI void retkv_stage(lds_t* lds, float l2g, int tid, const KvRegs& R) {
    lds_t* Ks = lds; lds_t* Vs = lds + 64 * 272;
#pragma unroll
    for (int i = 0; i < 2; ++i) { const int v = tid + 512 * i, j = v >> 4, d0 = (v & 15) * 8;
        const float dec = exp2f((float)(63 - j) * l2g); const u32x4 kv = R.k[i];
        u32x4 ks;
        ks.x = pk(bflo(kv.x) * dec, bfhi(kv.x) * dec); ks.y = pk(bflo(kv.y) * dec, bfhi(kv.y) * dec);
        ks.z = pk(bflo(kv.z) * dec, bfhi(kv.z) * dec); ks.w = pk(bflo(kv.w) * dec, bfhi(kv.w) * dec);
        *(LAS u32x4*)(Ks + j * 272 + d0 * 2) = ks; *(LAS u32x4*)(Vs + j * 272 + d0 * 2) = R.v[i]; }
}
DI void retkv_compute(lds_t* lds, const Params& P, bool samp, int b, int c, int h, float l2g, int wave, int lane) {
    lds_t* Ks = lds; lds_t* Vs = lds + 64 * 272;
    f32x4 acc[8];
#pragma unroll
    for (int et = 0; et < 8; ++et) acc[et] = (f32x4){0.f, 0.f, 0.f, 0.f};
#pragma unroll
    for (int ks = 0; ks < 2; ++ks) {
        const bf16x8 a = frag_T(Ks, 272, 32 * ks, 16 * wave, lane);
#pragma unroll
        for (int et = 0; et < 8; ++et) acc[et] = mfma16(a, frag_T(Vs, 272, 32 * ks, 16 * et, lane), acc[et]);
    }
    const int g = lane >> 4, l15 = lane & 15;
    if (!samp) {
        bf16_t* U = (bf16_t*)(P.ws + WS_US) + ((size_t)(b * 32 + c) * 4 + h) * 16384;
#pragma unroll
        for (int et = 0; et < 8; ++et) { u32x2 w = {pk(acc[et][0], acc[et][1]), pk(acc[et][2], acc[et][3])}; *(u32x2*)(U + (16 * et + l15) * 128 + 16 * wave + 4 * g) = w; }
    } else {
        const float g64 = exp2f(64.0f * l2g);
        const float* S0 = P.state + (size_t)(b * 4 + h) * 16384; float* O = P.out + O_NRS + (size_t)(b * 4 + h) * 16384;
#pragma unroll
        for (int et = 0; et < 8; ++et)
#pragma unroll
            for (int i = 0; i < 4; ++i) { const int o = (16 * wave + 4 * g + i) * 128 + 16 * et + l15; O[o] = g64 * S0[o] + acc[et][i]; }
    }
}
DI void retkv_loop(lds_t* lds, const Params& P, int u_lo, int u_hi, int first, int G, int tid, int wave, int lane) {
    const bf16_t* Z = (const bf16_t*)(P.ws + WS_Z);
    KvRegs R; int u = u_lo + first;
    if (u < u_hi) retkv_load(Z, u, tid, R);
    for (; u < u_hi; u += G) {
        bool samp; int b, c, h, row0; ret_decode(u, samp, b, c, h, row0);
        const float l2g = log2_gamma(h);
        retkv_stage(lds, l2g, tid, R);
        __syncthreads();
        if (u + G < u_hi) retkv_load(Z, u + G, tid, R);
        retkv_compute(lds, P, samp, b, c, h, l2g, wave, lane);
        __syncthreads();
    }
}

DI void ret_scan(const Params& P, int G, int bx, int tid) {
    const bf16_t* US = (const bf16_t*)(P.ws + WS_US); bf16_t* SB = (bf16_t*)(P.ws + WS_SB);
    for (int idx = bx * 512 + tid; idx < NB * 4 * 4096; idx += G * 512) {
        const int bh = idx >> 12, e4 = (idx & 4095) * 4, b = bh >> 2, h = bh & 3;
        const float g64 = exp2f(64.0f * log2_gamma(h));
        f32x4 s = {0.f, 0.f, 0.f, 0.f};
#pragma unroll 8
        for (int c = 0; c < 32; ++c) {
            const size_t o = ((size_t)(b * 32 + c) * 4 + h) * 16384 + e4;
            const u32x2 ub = __builtin_nontemporal_load((const u32x2*)(US + o));
            s = s * g64 + (f32x4){bflo(ub.x), bfhi(ub.x), bflo(ub.y), bfhi(ub.y)};
            u32x2 w = {pk(s[0], s[1]), pk(s[2], s[3])};
            *(u32x2*)(SB + o) = w;
        }
        const int e = e4 >> 7, dk = e4 & 127;
        float* o = P.out + O_NRP + (size_t)bh * 16384 + e;
#pragma unroll
        for (int i = 0; i < 4; ++i) o[(dk + i) * 128] = s[i];
    }
}

struct OutRegs { u32x4 q[2], k[2], v[2], s[4]; u32x2 gt[4]; };
DI void retout_load(const Params& P, int ru, int tid, int wave, int lane, OutRegs& R) {
    const bf16_t* Z = (const bf16_t*)(P.ws + WS_Z);
    bool samp; int b, c, h, row0; ret_decode(ru, samp, b, c, h, row0);
#pragma unroll
    for (int i = 0; i < 2; ++i) { const int v = tid + 512 * i, j = v >> 4, d0 = (v & 15) * 8; const bf16_t* zr = Z + (size_t)(row0 + j) * INW;
        R.q[i] = __builtin_nontemporal_load((const u32x4*)(zr + 768 + 128 * h + d0)); R.k[i] = __builtin_nontemporal_load((const u32x4*)(zr + 1280 + 128 * h + d0)); R.v[i] = __builtin_nontemporal_load((const u32x4*)(zr + 1792 + 128 * h + d0)); }
    const bf16_t* S = (const bf16_t*)(P.ws + WS_SB) + ((size_t)(b * 32 + (c > 0 ? c - 1 : 0)) * 4 + h) * 16384;
#pragma unroll
    for (int i = 0; i < 4; ++i) { const int v = tid + 512 * i, dk = v >> 4, e0 = (v & 15) * 8; R.s[i] = (u32x4){0u, 0u, 0u, 0u}; if (c > 0) R.s[i] = __builtin_nontemporal_load((const u32x4*)(S + dk * 128 + e0)); }
    const int g = lane >> 4, i_ = 16 * (wave & 3) + (lane & 15), eh = wave >> 2;
#pragma unroll
    for (int et = 0; et < 4; ++et) R.gt[et] = *(const u32x2*)(Z + (size_t)(row0 + i_) * INW + 2304 + 128 * h + 64 * eh + 16 * et + 4 * g);
}
DI void retout_stage(lds_t* lds, int tid, const OutRegs& R) {
    lds_t* Qs = lds; lds_t* Ks = lds + 17408; lds_t* Vs = lds + 2 * 17408; lds_t* Ss = lds + 3 * 17408;
#pragma unroll
    for (int i = 0; i < 2; ++i) { const int v = tid + 512 * i, j = v >> 4, d0 = (v & 15) * 8;
        *(LAS u32x4*)(Qs + j * 272 + d0 * 2) = R.q[i]; *(LAS u32x4*)(Ks + j * 272 + d0 * 2) = R.k[i]; *(LAS u32x4*)(Vs + j * 272 + d0 * 2) = R.v[i]; }
#pragma unroll
    for (int i = 0; i < 4; ++i) { const int v = tid + 512 * i, dk = v >> 4, e0 = (v & 15) * 8; *(LAS u32x4*)(Ss + dk * 272 + e0 * 2) = R.s[i]; }
}
DI void retout_compute(lds_t* lds, const Params& P, int row0, int h, float l2g, bool has_state, int wave, int lane, const u32x2 (&gt)[4], bool wt) {
    bf16_t* MIX = (bf16_t*)(P.ws + WS_MIX);
    lds_t* Qs = lds; lds_t* Ks = lds + 17408; lds_t* Vs = lds + 2 * 17408; lds_t* Ss = lds + 3 * 17408; LAS float* ssx = (LAS float*)(lds + 3 * 17408 + 128 * 272);
    const int g = lane >> 4, l15 = lane & 15, it = wave & 3, eh = wave >> 2;
    const int i_ = 16 * it + l15;
    bf16x8 qf[4];
#pragma unroll
    for (int ks = 0; ks < 4; ++ks) qf[ks] = frag_N(Qs, 272, 16 * it, 32 * ks, lane);
    f32x4 p[4];
#pragma unroll
    for (int jt = 0; jt < 4; ++jt) {
        f32x4 a = {0.f, 0.f, 0.f, 0.f};
        if (jt <= it) {
#pragma unroll
            for (int ks = 0; ks < 4; ++ks) a = mfma16(frag_N(Ks, 272, 16 * jt, 32 * ks, lane), qf[ks], a);
#pragma unroll
            for (int i = 0; i < 4; ++i) { const int j_ = 16 * jt + 4 * g + i; a[i] = (i_ >= j_) ? a[i] * exp2f((float)(i_ - j_) * l2g) : 0.f; }
        }
        p[jt] = a;
    }
    const bf16x8 pf0 = pack8(p[0], p[1]), pf1 = pack8(p[2], p[3]);
    f32x4 acc[4];
    const float qdec = exp2f((float)(i_ + 1) * l2g);
    float ss = 0.f;
#pragma unroll
    for (int et = 0; et < 4; ++et) {
        const int e0 = 64 * eh + 16 * et;
        f32x4 a = {0.f, 0.f, 0.f, 0.f};
        if (has_state) {
#pragma unroll
            for (int ks = 0; ks < 4; ++ks) a = mfma16(frag_N(Ss, 272, e0, 32 * ks, lane), qf[ks], a);
            a = a * qdec;
        }
        a = mfma16(frag_Tp(Vs, 272, 0, e0, lane), pf0, a);
        a = mfma16(frag_Tp(Vs, 272, 32, e0, lane), pf1, a);
        acc[et] = a;
        ss += (a[0] * a[0] + a[1] * a[1]) + (a[2] * a[2] + a[3] * a[3]);
    }
    ss += __shfl_xor(ss, 16); ss += __shfl_xor(ss, 32);
    if (g == 0) ssx[eh * 64 + i_] = ss;
    __syncthreads();
    const float rn = rsqrtf((ssx[i_] + ssx[64 + i_]) * (1.0f / 128.0f) + EPS);
    const size_t row = (size_t)(row0 + i_);
#pragma unroll
    for (int et = 0; et < 4; ++et) {
        const int e = 64 * eh + 16 * et + 4 * g;
        const float g0 = bflo(gt[et].x), g1 = bfhi(gt[et].x), g2 = bflo(gt[et].y), g3 = bfhi(gt[et].y);
        const float o0 = acc[et][0] * rn * (g0 / (1.0f + __expf(-g0))), o1 = acc[et][1] * rn * (g1 / (1.0f + __expf(-g1)));
        const float o2 = acc[et][2] * rn * (g2 / (1.0f + __expf(-g2))), o3 = acc[et][3] * rn * (g3 / (1.0f + __expf(-g3)));
        u32x2 w = {pk(o0, o1), pk(o2, o3)};
        st8(MIX + row * DM + 512 + 128 * h + e, w, wt);
    }
}
DI void retout_prompt_loop(lds_t* lds, const Params& P, int G, int bx, int tid, int wave, int lane) {
    OutRegs R; int u = bx;
    if (u < 1024) retout_load(P, u, tid, wave, lane, R);
    for (; u < 1024; u += G) {
        bool samp; int b, c, h, row0; ret_decode(u, samp, b, c, h, row0);
        retout_stage(lds, tid, R);
        u32x2 gt[4];
#pragma unroll
        for (int et = 0; et < 4; ++et) gt[et] = R.gt[et];
        __syncthreads();
        if (u + G < 1024) retout_load(P, u + G, tid, wave, lane, R);
        retout_compute(lds, P, row0, h, log2_gamma(h), true, wave, lane, gt, false);
        __syncthreads();
    }
}
DI void retout_sample_unit(lds_t* lds, const Params& P, int ru, int tid, int wave, int lane) {
    const bf16_t* Z = (const bf16_t*)(P.ws + WS_Z);
    bool samp; int b, c, h, row0; ret_decode(ru, samp, b, c, h, row0);
    lds_t* Qs = lds; lds_t* Ks = lds + 17408; lds_t* Vs = lds + 2 * 17408; lds_t* Ss = lds + 3 * 17408;
    for (int v = tid; v < 1024; v += 512) {
        const int j = v >> 4, d0 = (v & 15) * 8;
        const bf16_t* zr = Z + (size_t)(row0 + j) * INW;
        *(LAS u32x4*)(Qs + j * 272 + d0 * 2) = *(const u32x4*)(zr + 768 + 128 * h + d0);
        *(LAS u32x4*)(Ks + j * 272 + d0 * 2) = *(const u32x4*)(zr + 1280 + 128 * h + d0);
        *(LAS u32x4*)(Vs + j * 272 + d0 * 2) = *(const u32x4*)(zr + 1792 + 128 * h + d0);
    }
    const float* S = P.state + (size_t)(b * 4 + h) * 16384;
    for (int v = tid; v < 2048; v += 512) { const int dk = v >> 4, e0 = (v & 15) * 8; const f32x4 a = *(const f32x4*)(S + dk * 128 + e0), a2 = *(const f32x4*)(S + dk * 128 + e0 + 4);
        const unsigned p0 = pk(a[0], a[1]), p1 = pk(a[2], a[3]), p2 = pk(a2[0], a2[1]), p3 = pk(a2[2], a2[3]);
        LAS unsigned short* d = (LAS unsigned short*)(Ss + e0 * 272 + dk * 2);
        d[0 * 136] = (unsigned short)p0; d[1 * 136] = (unsigned short)(p0 >> 16); d[2 * 136] = (unsigned short)p1; d[3 * 136] = (unsigned short)(p1 >> 16);
        d[4 * 136] = (unsigned short)p2; d[5 * 136] = (unsigned short)(p2 >> 16); d[6 * 136] = (unsigned short)p3; d[7 * 136] = (unsigned short)(p3 >> 16); }
    u32x2 gt[4];
    { const int g = lane >> 4, i_ = 16 * (wave & 3) + (lane & 15), eh = wave >> 2;
#pragma unroll
      for (int et = 0; et < 4; ++et) gt[et] = *(const u32x2*)(Z + (size_t)(row0 + i_) * INW + 2304 + 128 * h + 64 * eh + 16 * et + 4 * g); }
    __syncthreads();
    retout_compute(lds, P, row0, h, log2_gamma(h), true, wave, lane, gt, true);
    __syncthreads();
}

DI void final_norm(const Params& P, int G, int wave, int lane, float* dst) {
    const int gw = blockIdx.x * 8 + wave, NGW = G * 8;
    const bf16_t* h1b = (const bf16_t*)(P.ws + WS_H1B);
    for (int m = MP + gw; m < MT; m += NGW) {
        f32x4 v[4]; float s = 0.f;
#pragma unroll
        for (int j = 0; j < 4; ++j) { const u32x2 hb = *(const u32x2*)(h1b + (size_t)m * DM + 4 * lane + 256 * j); v[j] = (f32x4){bflo(hb.x), bfhi(hb.x), bflo(hb.y), bfhi(hb.y)}; }
        const bf16_t* sl = (const bf16_t*)(P.ws + WS_SLAB) + (size_t)(m - MP) * DM + 4 * lane;
#pragma unroll
        for (int q = 0; q < NSPLIT_DN; ++q)
#pragma unroll
            for (int j = 0; j < 4; ++j) { const u32x2 sb = *(const u32x2*)(sl + (size_t)q * ((size_t)MS * DM) + 256 * j); v[j] += (f32x4){bflo(sb.x), bfhi(sb.x), bflo(sb.y), bfhi(sb.y)}; }
#pragma unroll
        for (int j = 0; j < 4; ++j) s += (v[j][0] * v[j][0] + v[j][1] * v[j][1]) + (v[j][2] * v[j][2] + v[j][3] * v[j][3]);
        const float rs = rsqrtf(wave_sum(s) * (1.0f / DM) + EPS);
#pragma unroll
        for (int j = 0; j < 4; ++j) *(f32x4*)(dst + (size_t)m * DM + 4 * lane + 256 * j) = v[j] * rs * *(const f32x4*)(P.norm_f + 4 * lane + 256 * j);
    }
}

#ifndef USE_COOP
#define USE_COOP 1
#endif
__global__ void __launch_bounds__(512, 2) fwd_megakernel(Params P) {
    extern __shared__ __attribute__((aligned(16))) unsigned char lds_raw[];
    lds_t* lds = (lds_t*)lds_raw;
#define FRESH_IDS const int tid = tid_of(wave0), lane = tid & 63, wave = wave0; (void)lane; (void)wave
    const int G = gridDim.x, bx = (int)blockIdx.x;
    unsigned char* ws = P.ws;
    volatile LAS unsigned* misc = (volatile LAS unsigned*)(lds + 131072 + 512);
    const int wave0 = __builtin_amdgcn_readfirstlane((int)threadIdx.x >> 6);
    if (threadIdx.x < 2) misc[threadIdx.x] = 0u;
    __syncthreads();
    XcdBarrier bar = xcd_barrier_post((unsigned*)(ws + WS_BAR), misc); bar.w0 = wave0;
    const bool subset = G >= 128;
    const int NS2 = subset ? 16 : 0, NS4 = subset ? 64 : 0;

    { FRESH_IDS; p0_prologue(P, lds, G, tid, wave, lane, true); }
    xcd_barrier(bar);
    {
        pg8::Gemm g{(const bf16_t*)(ws + WS_XN), (const bf16_t*)(ws + WS_WIN), MT, INW, DM}; pg8::StaticOrder S; S.init(MT, INW, DM, G, bx);
        pg8::EpiInProj E{(bf16_t*)(ws + WS_Z), (const float*)(ws + WS_RS1), P.out};
        pg8::gemm_phase<pg8::EpiInProj, pg8::StaticOrder, true, true>(lds, g, S, E, wave0);
    }
    xcd_barrier(bar);
    {
      const int GP = G - NS2;
      unsigned* flag = (unsigned*)(ws + WS_FLAG);
      if (bx < GP) {
        { FRESH_IDS; int u = bx - 32 % GP; if (u < 0) u += GP; for (; u < 32; u += GP) attn_unit(lds, P, 512 + u, tid, wave, lane); }
        { FRESH_IDS; int u = bx - 64 % GP; if (u < 0) u += GP; for (; u < 64; u += GP) retout_sample_unit(lds, P, 1024 + u, tid, wave, lane); }
        if (NS2 > 0) {
            asm volatile("s_waitcnt vmcnt(0)" ::: "memory"); __syncthreads();
            if (wave0 == 0 && lane_id() == 0) __hip_atomic_fetch_add(flag, 1u, __ATOMIC_RELAXED, __HIP_MEMORY_SCOPE_AGENT);
        }
        { FRESH_IDS; int f = bx - 128 % GP; if (f < 0) f += GP; retkv_loop(lds, P, 1024, 1088, f, GP, tid, wave, lane); }
        { FRESH_IDS;
          const int vb = (GP % 8 == 0) ? (bx % 8) * (GP / 8) + bx / 8 : bx;
          attn_prompt_loop(lds, P, GP, vb, tid, wave, lane);
          retkv_loop(lds, P, 0, 1024, GP - 1 - vb, GP, tid, wave, lane);
        }
        { FRESH_IDS; p2_ffn_weights(P, lds, GP, bx, wave, lane); }
      } else {
        if (wave0 == 0) {
            unsigned sp = 0;
            while ((unsigned)__builtin_amdgcn_readfirstlane(__hip_atomic_load(flag, __ATOMIC_RELAXED, __HIP_MEMORY_SCOPE_AGENT)) < (unsigned)GP) { __builtin_amdgcn_s_sleep(8); if (++sp > (1u << 22)) break; }
            __builtin_amdgcn_fence(__ATOMIC_ACQUIRE, "agent");
            asm volatile("s_waitcnt vmcnt(0)" ::: "memory");
        }
        __syncthreads();
        pg8::Gemm g{(const bf16_t*)(ws + WS_MIX), (const bf16_t*)(ws + WS_WOUT), MT, DM, DM}; pg8::SubsetOrder S; S.init(MP / 256, DM / 256, DM, NS2, bx - GP);
        pg8::EpiOutProjDma E{(const bf16_t*)(ws + WS_XN), (bf16_t*)(ws + WS_H1B), (float*)(ws + WS_ROWSS2)};
        pg8::gemm_phase<pg8::EpiOutProjDma, pg8::SubsetOrder, true, true>(lds, g, S, E, wave0);
      }
    }
    xcd_barrier(bar);
    { FRESH_IDS; ret_scan(P, G, bx, tid); }
    xcd_barrier(bar);
    if (bx < NS4) {
        pg8::Gemm g{(const bf16_t*)(ws + WS_H1B), (const bf16_t*)(ws + WS_WUP), MT, FF, DM}; pg8::SubsetOrder S; S.init(MP / 256, FF / 256, DM, NS4, bx);
        pg8::EpiUp E{(const float*)(ws + WS_ROWSS2), (bf16_t*)(ws + WS_U)};
        pg8::gemm_phase<pg8::EpiUp, pg8::SubsetOrder, true, true>(lds, g, S, E, wave0);
    } else { FRESH_IDS; retout_prompt_loop(lds, P, G - NS4, bx - NS4, tid, wave, lane); }
    xcd_barrier(bar);
    {
        const int M5 = subset ? MP : MT;
        pg8::Gemm g{(const bf16_t*)(ws + WS_MIX), (const bf16_t*)(ws + WS_WOUT), M5, DM, DM}; pg8::StaticOrder S; S.init(M5, DM, DM, G, bx);
        if (G >= 256) {
            pg8::EpiOutProjDma E{(const bf16_t*)(ws + WS_XN), (bf16_t*)(ws + WS_H1B), (float*)(ws + WS_ROWSS2)};
            pg8::gemm_phase<pg8::EpiOutProjDma, pg8::StaticOrder, true, true>(lds, g, S, E, wave0);
        } else {
            pg8::EpiOutProj E{(const bf16_t*)(ws + WS_XN), (bf16_t*)(ws + WS_H1B), (float*)(ws + WS_ROWSS2)};
            pg8::gemm_phase<pg8::EpiOutProj, pg8::StaticOrder, true, true>(lds, g, S, E, wave0);
        }
    }
    xcd_barrier(bar);
    {
        const int M6 = subset ? MP : MT;
        pg8::Gemm g{(const bf16_t*)(ws + WS_H1B), (const bf16_t*)(ws + WS_WUP), M6, FF, DM}; pg8::StaticOrder S; S.init(M6, FF, DM, G, bx);
        pg8::EpiUp E{(const float*)(ws + WS_ROWSS2), (bf16_t*)(ws + WS_U)};
        pg8::gemm_phase<pg8::EpiUp, pg8::StaticOrder, true, true>(lds, g, S, E, wave0);
    }
    xcd_barrier(bar);
    {
        pg8::Gemm g{(const bf16_t*)(ws + WS_U), (const bf16_t*)(ws + WS_WDN), MT, DM, FF}; pg8::TailSplitOrder S; S.init(MP, DM, FF, G, bx, MS / 256, NSPLIT_DN);
        pg8::EpiDownNorm E{(const bf16_t*)(ws + WS_H1B), P.out + O_Y, (bf16_t*)(ws + WS_SLAB), P.norm_f, (float*)(ws + WS_XBUF), (unsigned*)(ws + WS_CNT)};
        pg8::gemm_phase<pg8::EpiDownNorm, pg8::TailSplitOrder, true, true>(lds, g, S, E, wave0);
    }
    xcd_barrier(bar);
    { FRESH_IDS; final_norm(P, G, wave, lane, P.out + O_Y); }
}


extern "C" void kernel_launch(void* const* d_in, const int* in_sizes, int n_in, void* d_out, int out_size, void* d_ws, size_t ws_size, hipStream_t stream) {
    static int grid = 0;
    if (grid == 0) {
        int dev = 0, cus = 0, per_cu = 0;
        hipGetDevice(&dev);
        hipDeviceGetAttribute(&cus, hipDeviceAttributeMultiprocessorCount, dev);
        if (hipFuncSetAttribute((const void*)fwd_megakernel, hipFuncAttributeMaxDynamicSharedMemorySize, LDS_BYTES) != hipSuccess) { fprintf(stderr, "hipFuncSetAttribute failed\n"); }
        if (hipOccupancyMaxActiveBlocksPerMultiprocessor(&per_cu, (const void*)fwd_megakernel, 512, LDS_BYTES) != hipSuccess || per_cu < 1) { fprintf(stderr, "occupancy query: %d\n", per_cu); per_cu = 1; }
        (void)hipGetLastError();
        grid = cus * per_cu;
        fprintf(stderr, "kernel_launch: cus %d per_cu %d grid %d ws %zu\n", cus, per_cu, grid, ws_size);
    }
    hipMemsetAsync((char*)d_ws + WS_CNT, 0, (WS_BAR + 16384) - WS_CNT, stream);
    Params p{};
    p.xp = (const float*)d_in[0]; p.xs = (const float*)d_in[1]; p.cache_k = (const float*)d_in[2]; p.cache_v = (const float*)d_in[3]; p.state = (const float*)d_in[4];
    p.norm1 = (const float*)d_in[5]; p.w_in = (const float*)d_in[6]; p.sinks = (const float*)d_in[7]; p.w_out = (const float*)d_in[8]; p.norm2 = (const float*)d_in[9];
    p.w_up = (const float*)d_in[10]; p.w_down = (const float*)d_in[11]; p.norm_f = (const float*)d_in[12];
    p.out = (float*)d_out; p.ws = (unsigned char*)d_ws;
#if USE_COOP
    void* args[] = {&p};
    hipError_t e = hipLaunchCooperativeKernel((const void*)fwd_megakernel, dim3(grid), dim3(512), args, LDS_BYTES, stream);
    if (e != hipSuccess) fprintf(stderr, "cooperative launch failed: %s (grid %d)\n", hipGetErrorString(e), grid);
#else
    hipLaunchKernelGGL(fwd_megakernel, dim3(grid), dim3(512), LDS_BYTES, stream, p);
#endif
}
```
